# Optimizing an MI355X kernel written in HIP

```python
import jax, jax.numpy as jnp
from jax import lax
import numpy as np

D_MODEL = 1024
BATCH = 16
SEQ = 2048
DEPTH = 1

CHUNK = 64
FOX_HEADS = 16
HEAD_DIM = 64
FOX_WIDTH = FOX_HEADS * HEAD_DIM
CONV_GROUPS = 16
CONV_WIDTH = D_MODEL
D_MIX = FOX_WIDTH + CONV_WIDTH
CONV_KERNEL = 31
Q_BLOCK = 128
EPS = 1e-6
NEG_INF = -1e30
IN_COLS = 3 * FOX_WIDTH + FOX_HEADS + FOX_WIDTH + 2 * CONV_WIDTH + CONV_WIDTH

kernel_name = "hybrid_fox_conformer_block"


def rmsnorm(x, g):
    xf = x.astype(jnp.float32)
    y = xf * lax.rsqrt(jnp.mean(xf * xf, axis=-1, keepdims=True) + EPS)
    return (y * g.astype(jnp.float32)).astype(x.dtype)


def layernorm(x, g, b):
    xf = x.astype(jnp.float32)
    mu = jnp.mean(xf, axis=-1, keepdims=True)
    var = jnp.mean(jnp.square(xf - mu), axis=-1, keepdims=True)
    y = (xf - mu) * lax.rsqrt(var + EPS)
    return (y * g.astype(jnp.float32) + b.astype(jnp.float32)).astype(x.dtype)


def fox_attention(q, k, v, log_f):
    S = q.shape[1]
    c = jnp.cumsum(log_f, axis=1)
    c = jnp.transpose(c, (0, 2, 1))
    scale = HEAD_DIM ** -0.5
    outs = []
    for i in range(S // Q_BLOCK):
        q0, q1 = i * Q_BLOCK, (i + 1) * Q_BLOCK
        qb = q[:, q0:q1].astype(jnp.float32)
        kb = k[:, :q1].astype(jnp.float32)
        vb = v[:, :q1]
        logits = jnp.einsum('bqhd,bkhd->bhqk', qb, kb) * scale
        decay = c[:, :, q0:q1, None] - c[:, :, None, :q1]
        qpos = jnp.arange(q0, q1)[:, None]
        kpos = jnp.arange(q1)[None, :]
        logits = jnp.where(kpos <= qpos, logits + decay, NEG_INF)
        probs = jax.nn.softmax(logits, axis=-1).astype(v.dtype)
        outs.append(jnp.einsum('bhqk,bkhd->bqhd', probs, vb))
    return jnp.concatenate(outs, axis=1)


def causal_depthwise_conv(u, w, b):
    C = u.shape[-1]
    y = lax.conv_general_dilated(
        u, w.reshape(CONV_KERNEL, 1, C).astype(u.dtype),
        window_strides=(1,), padding=[(CONV_KERNEL - 1, 0)],
        dimension_numbers=('NWC', 'WIO', 'NWC'), feature_group_count=C)
    return y + b.astype(u.dtype)


def setup_inputs(seed: int = 0) -> dict:
    key = jax.random.key(seed)
    ks = jax.random.split(key, 12)
    f32 = jnp.float32
    x = jax.random.normal(ks[0], (BATCH, SEQ, D_MODEL), f32)
    norm_g = 1.0 + 0.02 * jax.random.normal(ks[1], (DEPTH, D_MODEL), f32)
    w_in = jax.random.normal(ks[2], (DEPTH, D_MODEL, IN_COLS), f32) * D_MODEL ** -0.5
    b_forget = (jnp.linspace(1.0, 5.0, FOX_HEADS, dtype=f32)[None, :]
                + 0.1 * jax.random.normal(ks[3], (DEPTH, FOX_HEADS), f32))
    q_norm_g = 1.0 + 0.02 * jax.random.normal(ks[4], (DEPTH, FOX_HEADS, HEAD_DIM), f32)
    k_norm_g = 1.0 + 0.02 * jax.random.normal(ks[5], (DEPTH, FOX_HEADS, HEAD_DIM), f32)
    conv_w = jax.random.normal(ks[6], (DEPTH, CONV_KERNEL, CONV_WIDTH), f32) * CONV_KERNEL ** -0.5
    conv_b = 0.02 * jax.random.normal(ks[7], (DEPTH, CONV_WIDTH), f32)
    conv_ln_g = 1.0 + 0.02 * jax.random.normal(ks[8], (DEPTH, CONV_WIDTH), f32)
    conv_ln_b = 0.02 * jax.random.normal(ks[9], (DEPTH, CONV_WIDTH), f32)
    w_out = jax.random.normal(ks[10], (DEPTH, D_MIX, D_MODEL), f32) * D_MIX ** -0.5
    return {"x": x, "norm_g": norm_g, "w_in": w_in, "b_forget": b_forget,
            "q_norm_g": q_norm_g, "k_norm_g": k_norm_g, "conv_w": conv_w,
            "conv_b": conv_b, "conv_ln_g": conv_ln_g, "conv_ln_b": conv_ln_b,
            "w_out": w_out}


def reference(x, norm_g, w_in, b_forget, q_norm_g, k_norm_g, conv_w, conv_b,
              conv_ln_g, conv_ln_b, w_out):
    B, S, _ = x.shape
    o_q = 0
    o_k = o_q + FOX_WIDTH
    o_v = o_k + FOX_WIDTH
    o_f = o_v + FOX_WIDTH
    o_gf = o_f + FOX_HEADS
    o_glu = o_gf + FOX_WIDTH
    o_gc = o_glu + 2 * CONV_WIDTH
    for l in range(DEPTH):
        h = rmsnorm(x, norm_g[l])
        z = jnp.einsum('bsd,de->bse', h, w_in[l])

        q = z[..., o_q:o_k].reshape(B, S, FOX_HEADS, HEAD_DIM)
        k = z[..., o_k:o_v].reshape(B, S, FOX_HEADS, HEAD_DIM)
        v = z[..., o_v:o_f].reshape(B, S, FOX_HEADS, HEAD_DIM)
        q = rmsnorm(q, q_norm_g[l])
        k = rmsnorm(k, k_norm_g[l])
        log_f = jax.nn.log_sigmoid(z[..., o_f:o_gf].astype(jnp.float32)
                                   + b_forget[l].astype(jnp.float32))
        a = fox_attention(q, k, v, log_f).reshape(B, S, FOX_WIDTH)
        a = a * jax.nn.silu(z[..., o_gf:o_glu])

        u = z[..., o_glu:o_gc]
        u = u[..., :CONV_WIDTH] * jax.nn.sigmoid(u[..., CONV_WIDTH:])
        u = causal_depthwise_conv(u, conv_w[l], conv_b[l])
        u = jax.nn.silu(layernorm(u, conv_ln_g[l], conv_ln_b[l]))
        u = u * jax.nn.silu(z[..., o_gc:])

        y = jnp.concatenate([a, u], axis=-1)
        x = x + jnp.einsum('bse,ed->bsd', y, w_out[l])
    return x
```

```cpp
#include <hip/hip_runtime.h>
#include <hip/hip_cooperative_groups.h>
#include <cstdio>
#include <cstdint>
namespace cg = cooperative_groups;
#ifndef MK_PROBE
#define MK_PROBE 0
#endif
#ifndef MK_N_LAUNCHES
#define MK_N_LAUNCHES 1
#endif
namespace pg8 {
#define PG8_LAS __attribute__((address_space(3)))
typedef unsigned short bf16_t;
typedef short bf16x8 __attribute__((ext_vector_type(8)));
typedef float f32x4 __attribute__((ext_vector_type(4)));
typedef unsigned u32x4 __attribute__((ext_vector_type(4)));
constexpr int BM = 256, BK = 64, HALF = 128, HTB = HALF * BK * 2  , STAGE_BYTES = 8 * HTB, NXCD = 8, WGM = 2;

__host__ __device__ __forceinline__ int lds_byte(int r, int c) { const int st = (r >> 4) * 2 + (c >> 5), rr = r & 15, cc = c & 31, ob = rr * 64 + cc * 2; return st * 1024 + (ob ^ (((ob >> 9) & 1) << 5)); }
__host__ __device__ __forceinline__ void stage_rc(int b, int& R, int& C) { const int st = b / 1024, sb = b % 1024, swz = sb ^ (((sb >> 9) & 1) << 5); R = (st >> 1) * 16 + swz / 64; C = (st & 1) * 32 + (swz % 64) / 2; }
__host__ __device__ __forceinline__ int perm32(int rho) { const int n = rho >> 4, i = rho & 15; return 8 * (i >> 2) + 4 * n + (i & 3); }

struct Unit { int pm, pn; };
struct Gemm { const bf16_t* A; const bf16_t* Bt; int M, N, K; int lda; int ksplit; long ajump; };

struct StaticOrder {
    int nM, nN, nwg, G, c;
    __host__ __device__ void init(int M, int N, int G_, int c_) { nM = M / BM; nN = N / BM; nwg = nM * nN; G = G_; c = c_; }
    __host__ __device__ bool next(int i, Unit& u) const {
        const long L = (long)i * G + c; if (L >= nwg) return false;
        int wgid = (int)L; { const int q = nwg / NXCD, r = nwg % NXCD, xcd = wgid % NXCD, off = wgid / NXCD; wgid = (xcd < r ? xcd * (q + 1) : r * (q + 1) + (xcd - r) * q) + off; }
        const int nig = WGM * nN, gid = wgid / nig, fm = gid * WGM, gsz = (nM - fm) < WGM ? (nM - fm) : WGM;
        u.pm = fm + ((wgid % nig) % gsz); u.pn = (wgid % nig) / gsz; return true;
    }
    __device__ __forceinline__ void a_ready(const Unit&) const {}
    __device__ __forceinline__ void done(const Unit&) const {}
};
typedef __bf16 bf16x2v __attribute__((ext_vector_type(2)));
typedef float f32x2 __attribute__((ext_vector_type(2)));
__device__ __forceinline__ unsigned cvt_pk_bf16(float lo, float hi) { const f32x2 v = {lo, hi}; return __builtin_bit_cast(unsigned, __builtin_convertvector(v, bf16x2v)); }
constexpr float kEPS = 1e-6f, kLOG2E = 1.4426950408889634f, kC2 = 0.125f * 1.4426950408889634f;
__device__ __forceinline__ float sigmoid_f(float x) { return __builtin_amdgcn_rcpf(1.0f + __builtin_amdgcn_exp2f(-kLOG2E * x)); }
__device__ __forceinline__ f32x4 sigmoid4(f32x4 x) { const f32x4 t = x * (-kLOG2E); f32x4 e; e[0] = __builtin_amdgcn_exp2f(t[0]); e[1] = __builtin_amdgcn_exp2f(t[1]); e[2] = __builtin_amdgcn_exp2f(t[2]); e[3] = __builtin_amdgcn_exp2f(t[3]);
    e = e + 1.0f; f32x4 r; r[0] = __builtin_amdgcn_rcpf(e[0]); r[1] = __builtin_amdgcn_rcpf(e[1]); r[2] = __builtin_amdgcn_rcpf(e[2]); r[3] = __builtin_amdgcn_rcpf(e[3]); return r; }
__device__ __forceinline__ u32x4 pack8(f32x4 v0, f32x4 v1) { u32x4 w; w.x = cvt_pk_bf16(v0[0], v0[1]); w.y = cvt_pk_bf16(v0[2], v0[3]); w.z = cvt_pk_bf16(v1[0], v1[1]); w.w = cvt_pk_bf16(v1[2], v1[3]); return w; }
struct Epi1 {
    static constexpr bool PERM = true, AFTER_DRAIN = false;
    bf16_t* Z; const float* RS; const float *qg, *kg; PG8_LAS unsigned char* stg;
    static constexpr size_t ZS = (size_t)32 << 20;
    __device__ __forceinline__ void operator()(const f32x4 (&acc)[2][2][4][2], const Unit& u, int wr, int wc, int fr, int fq) const {
        const int pn = u.pn; const int row0 = u.pm * BM + wr * 64 + fr;
        float rsv[2][4];
#pragma unroll
        for (int ai = 0; ai < 2; ++ai)
#pragma unroll
            for (int m = 0; m < 4; ++m) rsv[ai][m] = RS[row0 + ai * HALF + m * 16];
        const int l_ = fr + 16 * fq, rr_ = l_ >> 3, cc_ = l_ & 7;
        PG8_LAS unsigned char* slab = stg + (wr * 4 + wc) * 2304;
        PG8_LAS u32x4* wp = (PG8_LAS u32x4*)(slab + fr * 144 + fq * 16); const PG8_LAS u32x4* rp = (const PG8_LAS u32x4*)(slab + rr_ * 144 + cc_ * 16);
        const size_t rowst = (size_t)(u.pm * BM + wr * 64 + rr_) * 1024;
#define EPI1_STORE128(basep, colw, AI, MM, W0, W1) do { wp[0] = (W0); wp[4] = (W1); asm volatile("s_waitcnt lgkmcnt(0)" ::: "memory"); const u32x4 a_ = rp[0], b_ = rp[72]; asm volatile("s_waitcnt lgkmcnt(0)" ::: "memory"); \
            bf16_t* d_ = (basep) + rowst + (size_t)((AI) * HALF + (MM) * 16) * 1024 + (colw) + 8 * cc_; *(u32x4*)d_ = a_; *(u32x4*)(d_ + 8 * 1024) = b_; } while (0)
        if (pn < 8) {
            const bool isq = pn < 4; const int sec = isq ? pn : pn - 4;
            bf16_t* base = Z + (isq ? 0 : ZS); const float* gp = (isq ? qg : kg) + (sec * 4 + wc) * 64 + 8 * fq; const float sc = isq ? kC2 : 1.0f;
            f32x4 g[2][2];
#pragma unroll
            for (int bj = 0; bj < 2; ++bj)
#pragma unroll
                for (int n = 0; n < 2; ++n) g[bj][n] = *(const f32x4*)(gp + 32 * bj + 4 * n) * sc;
#pragma unroll
            for (int ai = 0; ai < 2; ++ai)
#pragma unroll
                for (int m = 0; m < 4; ++m) {
                    float ss = 0.f;
#pragma unroll
                    for (int bj = 0; bj < 2; ++bj)
#pragma unroll
                        for (int n = 0; n < 2; ++n) { const f32x4 x = acc[ai][bj][m][n]; ss += (x[0] * x[0] + x[1] * x[1]) + (x[2] * x[2] + x[3] * x[3]); }
                    { const auto r_ = __builtin_amdgcn_permlane16_swap(__float_as_uint(ss), __float_as_uint(ss), false, false); ss = __uint_as_float(r_[0]) + __uint_as_float(r_[1]); }
                    { const auto r_ = __builtin_amdgcn_permlane32_swap(__float_as_uint(ss), __float_as_uint(ss), false, false); ss = __uint_as_float(r_[0]) + __uint_as_float(r_[1]); }
                    const float rs = rsv[ai][m];
                    const float rinv = rs * __builtin_amdgcn_rsqf(ss * rs * rs * (1.0f / 64.0f) + kEPS);
                    const u32x4 w0 = pack8(acc[ai][0][m][0] * rinv * g[0][0], acc[ai][0][m][1] * rinv * g[0][1]), w1 = pack8(acc[ai][1][m][0] * rinv * g[1][0], acc[ai][1][m][1] * rinv * g[1][1]);
                    EPI1_STORE128(base, sec * 256 + wc * 64, ai, m, w0, w1);
                }
        } else if (pn < 16 || pn >= 24) {
            const bool act = pn >= 12; const int sec = pn < 12 ? pn - 8 : (pn < 16 ? pn - 12 : pn - 24);
            bf16_t* base = Z + (size_t)(pn < 12 ? 2 : (pn < 16 ? 3 : 5)) * ZS;
#pragma unroll
            for (int ai = 0; ai < 2; ++ai)
#pragma unroll
                for (int m = 0; m < 4; ++m) { const float rs = rsv[ai][m]; u32x4 w[2];
#pragma unroll
                    for (int bj = 0; bj < 2; ++bj) { f32x4 v0 = acc[ai][bj][m][0] * rs, v1 = acc[ai][bj][m][1] * rs;
                        if (act) { v0 = v0 * sigmoid4(v0); v1 = v1 * sigmoid4(v1); }
                        w[bj] = pack8(v0, v1); }
                    EPI1_STORE128(base, sec * 256 + wc * 64, ai, m, w[0], w[1]); }
        } else {
            const int r4 = l_ >> 2, c4 = l_ & 3; const PG8_LAS u32x4* rp4 = (const PG8_LAS u32x4*)(slab + r4 * 144 + c4 * 16);
            bf16_t* ub = Z + 4 * ZS + (size_t)(u.pm * BM + wr * 64 + r4) * 1024 + (pn - 16) * 128 + wc * 32 + 8 * c4;
#pragma unroll
            for (int ai = 0; ai < 2; ++ai)
#pragma unroll
                for (int m = 0; m < 4; ++m) { const float rs = rsv[ai][m]; f32x4 v0 = acc[ai][0][m][0] * rs, v1 = acc[ai][0][m][1] * rs; const f32x4 g0 = acc[ai][1][m][0] * rs, g1 = acc[ai][1][m][1] * rs;
                    v0 = v0 * sigmoid4(g0); v1 = v1 * sigmoid4(g1);
                    wp[0] = pack8(v0, v1); asm volatile("s_waitcnt lgkmcnt(0)" ::: "memory"); const u32x4 a_ = rp4[0]; asm volatile("s_waitcnt lgkmcnt(0)" ::: "memory");
                    *(u32x4*)(ub + (size_t)(ai * HALF + m * 16) * 1024) = a_; }
        }
#undef EPI1_STORE128
    }
};
struct Epi2 {
    static constexpr bool PERM = true, AFTER_DRAIN = false;
    const float* __restrict__ x; float* __restrict__ out; PG8_LAS unsigned char* stg;
    __device__ __forceinline__ void operator()(const f32x4 (&acc)[2][2][4][2], const Unit& u, int wr, int wc, int fr, int fq) const {
        const int l = fr + 16 * fq, rr = l >> 3, cc = l & 7;
        PG8_LAS unsigned char* slab = stg + (wr * 4 + wc) * 2304;
        PG8_LAS f32x4* wp = (PG8_LAS f32x4*)(slab + fr * 144 + fq * 32); const PG8_LAS f32x4* rp = (const PG8_LAS f32x4*)(slab + rr * 144 + cc * 16);
        const size_t g0 = (size_t)(u.pm * BM + wr * 64 + rr) * 1024 + u.pn * BM + wc * 32 + 4 * cc;
        const float* __restrict__ xb = x + g0; float* __restrict__ ob = out + g0;
#pragma unroll
        for (int ai = 0; ai < 2; ++ai) {
            f32x4 pre[4][2][2];
#pragma unroll
            for (int m = 0; m < 4; ++m)
#pragma unroll
                for (int bj = 0; bj < 2; ++bj)
#pragma unroll
                    for (int r = 0; r < 2; ++r) pre[m][bj][r] = *(const f32x4*)(xb + (size_t)(ai * HALF + m * 16 + 8 * r) * 1024 + bj * HALF);
            asm volatile("" ::: "memory");
#pragma unroll
            for (int m = 0; m < 4; ++m)
#pragma unroll
                for (int bj = 0; bj < 2; ++bj) {
                    wp[0] = acc[ai][bj][m][0]; wp[1] = acc[ai][bj][m][1];
                    asm volatile("s_waitcnt lgkmcnt(0)" ::: "memory");
                    const f32x4 v0 = rp[0], v1 = rp[8 * 9];
                    asm volatile("s_waitcnt lgkmcnt(0)" ::: "memory");
                    *(f32x4*)(ob + (size_t)(ai * HALF + m * 16) * 1024 + bj * HALF) = pre[m][bj][0] + v0;
                    *(f32x4*)(ob + (size_t)(ai * HALF + m * 16 + 8) * 1024 + bj * HALF) = pre[m][bj][1] + v1;
                }
            asm volatile("" ::: "memory");
        }
    }
};
template <class Epi, class Sched, bool ALIGN_EPI = false, bool SP2 = false>
__device__ __forceinline__ void gemm_phase(PG8_LAS unsigned char* lds, const Gemm g, const Sched& S, const Epi& E) {
    int tid_ = threadIdx.x; asm volatile("" : "+v"(tid_));
    const int tid = tid_, wid = __builtin_amdgcn_readfirstlane(tid >> 6), lane = tid & 63, wr = wid >> 2, wc = wid & 3, fr = lane & 15, fq = lane >> 4;
    const int K = g.K, nt = K / BK;
    unsigned voffA[2], voffB[2];
#pragma unroll
    for (int i = 0; i < 2; ++i) { int R, C; stage_rc(tid * 16 + i * 8192, R, C); const int Rb = Epi::PERM ? ((R & ~31) + perm32(R & 31)) : R;
        voffA[i] = (unsigned)(R * g.lda + C) * 2u; voffB[i] = (unsigned)(Rb * K + C) * 2u; }
    const size_t kstep = (size_t)(BK * 2);
    const size_t hstepA = (size_t)HALF * g.lda * 2, hstepB = (size_t)HALF * K * 2;
    const size_t tstepA = 2 * hstepA, tstepB = 2 * hstepB;
    const int ksplit = g.ksplit; const long ajump = g.ajump;
#define PG8_KOFF(t) ((size_t)(t) * kstep + ((t) >= ksplit ? ajump : 0l))
    const unsigned ldsw = (unsigned)wid * 1024u;
    const int aoff = lds_byte(wr * 64 + fr, fq * 8), boff = lds_byte(wc * 32 + fr, fq * 8);
#define PG8_SA(b, h) (((b) * 2 + (h)) * HTB)
#define PG8_SB(b, h) ((4 + (b) * 2 + (h)) * HTB)
#define PG8_STAGE(bufoff, gbase, voff) do { _Pragma("unroll") for (int _i = 0; _i < 2; ++_i) \
        __builtin_amdgcn_global_load_lds((const unsigned*)((const char*)(gbase) + (voff)[_i]), (PG8_LAS unsigned*)(lds + (bufoff) + ldsw + _i * 8192), 16, 0, 0); } while (0)
#define PG8_LDA(dst, b, h) do { _Pragma("unroll") for (int m = 0; m < 4; ++m) _Pragma("unroll") for (int k = 0; k < 2; ++k) dst[m][k] = *(const PG8_LAS bf16x8*)(lds + PG8_SA(b, h) + aoff + m * 2048 + k * 1024); } while (0)
#define PG8_LDB(dst, b, h) do { _Pragma("unroll") for (int n = 0; n < 2; ++n) _Pragma("unroll") for (int k = 0; k < 2; ++k) dst[n][k] = *(const PG8_LAS bf16x8*)(lds + PG8_SB(b, h) + boff + n * 2048 + k * 1024); } while (0)
#define PG8_MMA(ai, bj, At, Bt) do { __builtin_amdgcn_s_setprio(1); _Pragma("unroll") for (int m = 0; m < 4; ++m) _Pragma("unroll") for (int n = 0; n < 2; ++n) _Pragma("unroll") for (int k = 0; k < 2; ++k) \
        acc[ai][bj][m][n] = __builtin_amdgcn_mfma_f32_16x16x32_bf16(Bt[n][k], At[m][k], acc[ai][bj][m][n], 0, 0, 0); __builtin_amdgcn_s_setprio(0); } while (0)
#define PG8_WAIT_V(n) asm volatile("s_waitcnt vmcnt(" #n ")" ::: "memory")
#define PG8_WAIT_L(n) asm volatile("s_waitcnt lgkmcnt(" #n ")" ::: "memory")
#define PG8_BAR __builtin_amdgcn_s_barrier()
#define PG8_SCHED __builtin_amdgcn_sched_barrier(0)
    Unit cur, nxt; int ui = 0;
    if (!S.next(0, cur)) return;
    f32x4 acc[2][2][4][2];
#pragma unroll
    for (int a = 0; a < 2; ++a)
#pragma unroll
        for (int b = 0; b < 2; ++b)
#pragma unroll
            for (int m = 0; m < 4; ++m)
#pragma unroll
                for (int n = 0; n < 2; ++n) acc[a][b][m][n] = (f32x4){0.f, 0.f, 0.f, 0.f};
    bf16x8 At[4][2], B0[2][2], B1[2][2];
    const char* cA = (const char*)g.A + (size_t)cur.pm * tstepA; const char* cB = (const char*)g.Bt + (size_t)cur.pn * tstepB;
    S.a_ready(cur);
    if constexpr (SP2) {
        PG8_STAGE(PG8_SB(0, 0), cB, voffB); PG8_STAGE(PG8_SB(0, 1), cB + hstepB, voffB); PG8_STAGE(PG8_SA(0, 0), cA, voffA); PG8_STAGE(PG8_SA(0, 1), cA + hstepA, voffA);
        if (wr == 1) PG8_BAR;
        PG8_WAIT_V(2); PG8_BAR;
        PG8_STAGE(PG8_SB(1, 0), cB + kstep, voffB); PG8_STAGE(PG8_SA(1, 0), cA + kstep, voffA); PG8_STAGE(PG8_SB(1, 1), cB + hstepB + kstep, voffB);
        PG8_WAIT_V(6); PG8_BAR;
    } else {
        PG8_STAGE(PG8_SB(0, 0), cB, voffB); PG8_STAGE(PG8_SA(0, 0), cA, voffA); PG8_STAGE(PG8_SB(0, 1), cB + hstepB, voffB); PG8_STAGE(PG8_SA(0, 1), cA + hstepA, voffA);
        if (wr == 1) PG8_BAR;
        PG8_WAIT_V(4); PG8_BAR;
        PG8_STAGE(PG8_SB(1, 0), cB + kstep, voffB); PG8_STAGE(PG8_SA(1, 0), cA + kstep, voffA); PG8_STAGE(PG8_SB(1, 1), cB + hstepB + kstep, voffB);
        PG8_WAIT_V(6); PG8_BAR;
    }
    for (;;) {
        const bool has_next = S.next(ui + 1, nxt);
        const char* nA = has_next ? (const char*)g.A + (size_t)nxt.pm * tstepA : cA; const char* nB = has_next ? (const char*)g.Bt + (size_t)nxt.pn * tstepB : cB;
        for (int t = 0; t < nt; t += 2) {
            const bool last = (t == nt - 2);
            const char* a1 = cA + PG8_KOFF(t + 1);
            const char* a2 = last ? nA : cA + PG8_KOFF(t + 2); const char* b2 = last ? nB : cB + (size_t)(t + 2) * kstep;
            const char* a3 = a2 + kstep; const char* b3 = b2 + kstep;
            if (last && has_next) S.a_ready(nxt);
            if constexpr (SP2) {
            PG8_LDB(B0, 0, 0); PG8_LDB(B1, 0, 1); PG8_SCHED; PG8_LDA(At, 0, 0); PG8_STAGE(PG8_SA(1, 1), a1 + hstepA, voffA);
            PG8_WAIT_V(8); PG8_WAIT_L(0); PG8_BAR; PG8_MMA(0, 0, At, B0); PG8_MMA(0, 1, At, B1); PG8_BAR; PG8_SCHED;
            PG8_LDA(At, 0, 1); PG8_STAGE(PG8_SB(0, 0), b2, voffB); PG8_STAGE(PG8_SB(0, 1), b2 + hstepB, voffB); PG8_STAGE(PG8_SA(0, 0), a2, voffA);
            PG8_WAIT_V(8); PG8_WAIT_L(0); PG8_BAR; PG8_MMA(1, 0, At, B0); PG8_MMA(1, 1, At, B1); PG8_BAR; PG8_SCHED;
            PG8_LDB(B0, 1, 0); PG8_LDB(B1, 1, 1); PG8_SCHED; PG8_LDA(At, 1, 0); PG8_STAGE(PG8_SA(0, 1), a2 + hstepA, voffA);
            PG8_WAIT_V(8); PG8_WAIT_L(0); PG8_BAR; PG8_MMA(0, 0, At, B0); PG8_MMA(0, 1, At, B1); PG8_BAR; PG8_SCHED;
            PG8_LDA(At, 1, 1); PG8_STAGE(PG8_SB(1, 0), b3, voffB); PG8_STAGE(PG8_SB(1, 1), b3 + hstepB, voffB); PG8_STAGE(PG8_SA(1, 0), a3, voffA);
            PG8_WAIT_V(8); PG8_WAIT_L(0); PG8_BAR; PG8_MMA(1, 0, At, B0); PG8_MMA(1, 1, At, B1); PG8_BAR; PG8_SCHED;
            } else {
            PG8_LDB(B0, 0, 0); PG8_SCHED; PG8_LDA(At, 0, 0); PG8_STAGE(PG8_SA(1, 1), a1 + hstepA, voffA);
            PG8_WAIT_L(8); PG8_BAR; PG8_WAIT_L(0); PG8_MMA(0, 0, At, B0); PG8_BAR; PG8_SCHED;
            PG8_LDB(B1, 0, 1); PG8_STAGE(PG8_SB(0, 0), b2, voffB);
            PG8_BAR; PG8_WAIT_L(0); PG8_MMA(0, 1, At, B1); PG8_BAR;
            PG8_LDA(At, 0, 1); PG8_STAGE(PG8_SA(0, 0), a2, voffA);
            PG8_BAR; PG8_WAIT_L(0); PG8_MMA(1, 0, At, B0); PG8_BAR; PG8_SCHED;
            PG8_STAGE(PG8_SB(0, 1), b2 + hstepB, voffB);
            PG8_WAIT_V(6); PG8_BAR; PG8_MMA(1, 1, At, B1); PG8_BAR;
            PG8_LDB(B0, 1, 0); PG8_SCHED; PG8_LDA(At, 1, 0); PG8_STAGE(PG8_SA(0, 1), a2 + hstepA, voffA);
            PG8_WAIT_L(8); PG8_BAR; PG8_WAIT_L(0); PG8_MMA(0, 0, At, B0); PG8_BAR; PG8_SCHED;
            PG8_LDB(B1, 1, 1); PG8_STAGE(PG8_SB(1, 0), b3, voffB);
            PG8_BAR; PG8_WAIT_L(0); PG8_MMA(0, 1, At, B1); PG8_BAR;
            PG8_LDA(At, 1, 1); PG8_STAGE(PG8_SA(1, 0), a3, voffA);
            PG8_BAR; PG8_WAIT_L(0); PG8_MMA(1, 0, At, B0); PG8_BAR; PG8_SCHED;
            PG8_STAGE(PG8_SB(1, 1), b3 + hstepB, voffB);
            PG8_WAIT_V(6); PG8_BAR; PG8_MMA(1, 1, At, B1); PG8_BAR;
            }
        }
        if constexpr (ALIGN_EPI) { if (wr == 0) PG8_BAR; }
        if constexpr (!Epi::AFTER_DRAIN) { E(acc, cur, wr, wc, fr, fq); S.done(cur); }
        if (!has_next) break;
#pragma unroll
        for (int a = 0; a < 2; ++a)
#pragma unroll
            for (int b = 0; b < 2; ++b)
#pragma unroll
                for (int m = 0; m < 4; ++m)
#pragma unroll
                    for (int n = 0; n < 2; ++n) acc[a][b][m][n] = (f32x4){0.f, 0.f, 0.f, 0.f};
        cur = nxt; cA = nA; cB = nB; ++ui;
        if constexpr (ALIGN_EPI) { if (wr == 1) PG8_BAR; }
    }
    PG8_WAIT_V(0);
    if constexpr (!ALIGN_EPI) { if (wr == 0) PG8_BAR; }
    PG8_BAR;
    if constexpr (Epi::AFTER_DRAIN) { E.fused(acc, cur, wr, wc, fr, fq, lds, wid, lane); S.done(cur); }
#undef PG8_SA
#undef PG8_KOFF
#undef PG8_SB
#undef PG8_STAGE
#undef PG8_LDA
#undef PG8_LDB
#undef PG8_MMA
#undef PG8_WAIT_V
#undef PG8_WAIT_L
#undef PG8_BAR
#undef PG8_SCHED
}
}
#include <hip/hip_bf16.h>
#include <cmath>
namespace attn_body {
using bf16=__hip_bfloat16;
using bf16x8=__attribute__((ext_vector_type(8)))short;
using s16x4=__attribute__((ext_vector_type(4)))short;
using f32x16=__attribute__((ext_vector_type(16)))float;
using u32x4=__attribute__((ext_vector_type(4)))unsigned;
constexpr int BATCH=16,NHEAD=16,SEQ=2048,D=64,DM=NHEAD*D;
constexpr int NW=8,QBLK=32,QB=QBLK*NW,KVBLK=64,NQB=SEQ/QB;
constexpr int ATTN_PITCH=DM, ATTN_UNIT_ROWS=QB;
__device__ __forceinline__ int crow(int r,int hi){return (r&3)+8*(r>>2)+4*hi;}
#define SBAR() __builtin_amdgcn_sched_barrier(0)
__device__ __forceinline__ void cmask(f32x16&p0,f32x16&p1,int jb,int qrel,int hi){
  const float NEG=-INFINITY; int kb=64*jb+4*hi;
  #pragma unroll
  for(int r=0;r<16;++r){int kv=kb+(r&3)+8*(r>>2); if(kv>qrel)p0[r]=NEG; if(kv+32>qrel)p1[r]=NEG;}
}

constexpr int NSLOT=3, SLOTB=8192;
constexpr int LDS_K=0, LDS_V=NSLOT*SLOTB, LDS_WS=2*NSLOT*SLOTB, LDS_OST=LDS_WS+NW*64*4, LDS_BYTES=LDS_OST+NW*4096;
constexpr float C2=0.125f*1.4426950408889634f;
__device__ __forceinline__ void glds16(const void*gsrc,unsigned lds_dst){unsigned keep;
  asm volatile("s_mov_b32 %0, m0\n\ts_mov_b32 m0, %2\n\ts_nop 0\n\tglobal_load_lds_dwordx4 %1, off\n\ts_mov_b32 m0, %0":"=&s"(keep):"v"(gsrc),"s"(lds_dst):"memory");}
__device__ __forceinline__ float max3f(float a,float b,float c){float r;asm("v_max3_f32 %0, %1, %2, %3":"=v"(r):"v"(a),"v"(b),"v"(c));return r;}
__device__ __forceinline__ float max2f(float a,float b){float r;asm("v_max_f32_e32 %0, %1, %2":"=v"(r):"v"(a),"v"(b));return r;}
__device__ __forceinline__ float fadd_s(float a,float b){float r;asm("v_add_f32_e32 %0, %1, %2":"=v"(r):"v"(a),"v"(b));return r;}
__device__ __forceinline__ float fsub_s(float a,float b){float r;asm("v_sub_f32_e32 %0, %1, %2":"=v"(r):"v"(a),"v"(b));return r;}
typedef float f32x2_t __attribute__((ext_vector_type(2))); typedef __bf16 bf16x2_t __attribute__((ext_vector_type(2)));
__device__ __forceinline__ unsigned cvtpk_s(float lo,float hi){f32x2_t v={lo,hi};bf16x2_t b=__builtin_convertvector(v,bf16x2_t);return __builtin_bit_cast(unsigned,b);}
#define WAIT_BAR(N) asm volatile("s_waitcnt vmcnt(" #N ") lgkmcnt(0)\n\ts_barrier":::"memory")

__device__ __forceinline__ void qkt(f32x16&p0,f32x16&p1,const char*Kslot,const bf16x8*qr,int r32,int hi,s16x4 ka0,s16x4 ka1,s16x4 qaug){
  const f32x16 zero=f32x16{};
  const char*kb=Kslot+hi*1024+r32*16;
  #pragma unroll
  for(int d0=0;d0<4;++d0){
    const bf16x8 b0=*reinterpret_cast<const bf16x8*>(kb+d0*2048);
    const bf16x8 b1=*reinterpret_cast<const bf16x8*>(kb+d0*2048+512);
    if(d0==0){p0=__builtin_amdgcn_mfma_f32_32x32x16_bf16(b0,qr[0],zero,0,0,0);p1=__builtin_amdgcn_mfma_f32_32x32x16_bf16(b1,qr[0],zero,0,0,0);}
    else{p0=__builtin_amdgcn_mfma_f32_32x32x16_bf16(b0,qr[d0],p0,0,0,0);p1=__builtin_amdgcn_mfma_f32_32x32x16_bf16(b1,qr[d0],p1,0,0,0);}}
  p0=__builtin_amdgcn_mfma_f32_32x32x8bf16_1k(ka0,qaug,p0,0,0,0);p1=__builtin_amdgcn_mfma_f32_32x32x8bf16_1k(ka1,qaug,p1,0,0,0);
}
typedef __attribute__((address_space(3))) const char* lds_cptr;
typedef short v4i16_t __attribute__((ext_vector_type(4)));
__device__ __forceinline__ void kload8(bf16x8*kf,lds_cptr kp){
  kf[0]=*(const __attribute__((address_space(3))) bf16x8*)(kp);      kf[1]=*(const __attribute__((address_space(3))) bf16x8*)(kp+512);
  kf[2]=*(const __attribute__((address_space(3))) bf16x8*)(kp+2048); kf[3]=*(const __attribute__((address_space(3))) bf16x8*)(kp+2560);
  kf[4]=*(const __attribute__((address_space(3))) bf16x8*)(kp+4096); kf[5]=*(const __attribute__((address_space(3))) bf16x8*)(kp+4608);
  kf[6]=*(const __attribute__((address_space(3))) bf16x8*)(kp+6144); kf[7]=*(const __attribute__((address_space(3))) bf16x8*)(kp+6656);
}
__device__ __forceinline__ void kload2(bf16x8*kf,lds_cptr kp,int j){ kf[2*j]=*(const __attribute__((address_space(3))) bf16x8*)(kp+j*2048); kf[2*j+1]=*(const __attribute__((address_space(3))) bf16x8*)(kp+j*2048+512); }
__device__ __forceinline__ s16x4 vtr(lds_cptr p){ return __builtin_bit_cast(s16x4,__builtin_amdgcn_ds_read_tr16_b64_v4i16((__attribute__((address_space(3))) v4i16_t*)p)); }
__device__ __forceinline__ float rowmax(const f32x16&p0,const f32x16&p1){
  float a=max3f(p0[0],p0[1],p1[0]),b=max3f(p0[2],p0[3],p1[1]);a=max3f(a,p1[2],p1[3]);
  #pragma unroll
  for(int r=4;r<16;r+=4){a=max3f(a,p0[r],p0[r+1]);b=max3f(b,p0[r+2],p0[r+3]);a=max3f(a,p1[r],p1[r+1]);b=max3f(b,p1[r+2],p1[r+3]);}
  const float m=max2f(a,b);
  auto rr=__builtin_amdgcn_permlane32_swap(__float_as_uint(m),__float_as_uint(m),false,false);
  return max2f(__uint_as_float(rr[0]),__uint_as_float(rr[1]));
}
__device__ __forceinline__ void pv(f32x16*o,int vb,bf16x8 pa0,bf16x8 pa1,bf16x8 pa2,bf16x8 pa3){
  #pragma unroll
  for(int d0=0;d0<2;++d0){s16x4 lo[4],hi[4];
    #pragma unroll
    for(int ks=0;ks<4;++ks){
      asm volatile("ds_read_b64_tr_b16 %0,%1 offset:%c2":"=&v"(lo[ks]):"v"(vb),"i"(d0*4096+ks*1024):"memory");
      asm volatile("ds_read_b64_tr_b16 %0,%1 offset:%c2":"=&v"(hi[ks]):"v"(vb),"i"(d0*4096+ks*1024+512):"memory");}
    asm volatile("s_waitcnt lgkmcnt(0)":::"memory");SBAR();
    #define PK(k) (bf16x8){lo[k][0],lo[k][1],lo[k][2],lo[k][3],hi[k][0],hi[k][1],hi[k][2],hi[k][3]}
    o[d0]=__builtin_amdgcn_mfma_f32_32x32x16_bf16(pa0,PK(0),o[d0],0,0,0);
    o[d0]=__builtin_amdgcn_mfma_f32_32x32x16_bf16(pa1,PK(1),o[d0],0,0,0);
    o[d0]=__builtin_amdgcn_mfma_f32_32x32x16_bf16(pa2,PK(2),o[d0],0,0,0);
    o[d0]=__builtin_amdgcn_mfma_f32_32x32x16_bf16(pa3,PK(3),o[d0],0,0,0);
    #undef PK
  }
}

#ifndef ATTN_STORE16
#define ATTN_STORE16(p,v) (*(u32x4*)(p)=(v))
#endif
template<int THRL> __device__ __forceinline__ void attn_unit(int b,int h,int qb,const bf16*Q,const bf16*__restrict__ K,const bf16*__restrict__ V,bf16*O,const bf16*__restrict__ GF,char*shm,lds_cptr btab){
  int tid_=threadIdx.x; asm volatile("":"+v"(tid_)); const int tid=tid_,lane=tid&63,r32=lane&31,hi=lane>>5; const int wid=__builtin_amdgcn_readfirstlane(tid>>6);
  const long rowbase=(long)b*SEQ; const int q0=qb*QB;
  const bf16*Qw=Q+(rowbase+q0+wid*QBLK)*DM+h*D;
  const bf16*Kh=K+rowbase*DM+h*D,*Vh=V+rowbase*DM+h*D;
  const unsigned lds0=(unsigned)(uintptr_t)shm;
  float*wsf=(float*)(shm+LDS_WS)+wid*64;
  const bf16*ksrc=Kh+(long)lane*DM+wid*8;
  const bf16*vsrc=Vh+(long)(16*(wid&3)+(lane>>2))*DM+(wid>>2)*32+(lane&3)*8;
  const unsigned kdst=lds0+LDS_K+wid*1024, vdst=lds0+LDS_V+wid*1024;
  #define DMA_K(t,slot) glds16(ksrc+(long)(t)*KVBLK*DM,(unsigned)__builtin_amdgcn_readfirstlane(kdst+(slot)))
  #define DMA_V(t,slot) glds16(vsrc+(long)(t)*KVBLK*DM,(unsigned)__builtin_amdgcn_readfirstlane(vdst+(slot)))
  const int vb0=(int)(lds0+LDS_V)+((lane>>4)&1)*32+(lane&3)*8+(4*hi+((lane&15)>>2))*64;
  const char*Kbase=shm+LDS_K; bf16x8 kf[8];
  const lds_cptr shm3=(lds_cptr)shm; const lds_cptr kp0=shm3+LDS_K+hi*1024+r32*16; const lds_cptr vp0=shm3+LDS_V+((lane>>4)&1)*32+(lane&3)*8+(4*hi+((lane&15)>>2))*64;
  const int NT=(q0+QB)/KVBLK;
  DMA_K(0,0);DMA_V(0,0);DMA_K(1,SLOTB);
  bf16x8 qr[4];
  #pragma unroll
  for(int d0=0;d0<4;++d0)qr[d0]=*reinterpret_cast<const bf16x8*>(&Qw[(long)r32*DM+d0*16+hi*8]);
  typedef unsigned u32x2_t __attribute__((ext_vector_type(2)));
  const lds_cptr bt0=btab+r32*16+hi*8;
  #define KAUG(t,half) __builtin_bit_cast(s16x4,*(const __attribute__((address_space(3))) u32x2_t*)(bt0+((t)*64+(half)*32)*16))
  u32x2_t qaw=hi?(u32x2_t){0u,0u}:(u32x2_t){0x3F803F80u,0x00003F80u};
  #define QAUG __builtin_bit_cast(s16x4,qaw)
  #define SETQ() do{ const float nm_=-mhat; const unsigned m1_=cvtpk_s(nm_,0.f)&0xffffu; const float r1_=nm_-__uint_as_float(m1_<<16); const unsigned m2_=cvtpk_s(r1_,0.f)&0xffffu; const float r2_=r1_-__uint_as_float(m2_<<16); \
    const unsigned m3_=cvtpk_s(r2_,0.f)&0xffffu; qaw=hi?(u32x2_t){m2_|(m3_<<16),0u}:(u32x2_t){0x3F803F80u,0x3F80u|(m1_<<16)}; }while(0)
  typedef unsigned u32x2_t __attribute__((ext_vector_type(2)));
  float mhat=0.f,l_reg=0.f;f32x16 o[2];o[0]=f32x16{};o[1]=f32x16{};const f32x16 zero16=f32x16{};
  const int qrel=wid*QBLK+r32;
  #define CMASK(P0,P1,t) do{int jb_=(t)-(NT-4); if(jb_>=0)cmask(P0,P1,jb_,qrel,hi);}while(0)
  bool resc=false;
  #define START(P0,P1) do{ const float rm=rowmax(P0,P1); resc=false; \
    { const float dl=rm; mhat=fadd_s(mhat,dl); \
      _Pragma("unroll") for(int r=0;r<16;++r){P0[r]=fsub_s(P0[r],dl);P1[r]=fsub_s(P1[r],dl);} \
      SETQ(); } \
    _Pragma("unroll") for(int r=0;r<16;++r)P0[r]=__builtin_amdgcn_exp2f(P0[r]); }while(0)
  #define RESC() do{ if(resc){ asm volatile("s_waitcnt lgkmcnt(0)":::"memory"); \
      _Pragma("unroll") for(int d_=0;d_<2;++d_) _Pragma("unroll") for(int r=0;r<16;++r)o[d_][r]*=wsf[crow(r,hi)]; } }while(0)
  f32x16 pA0,pA1,pB0,pB1;
  int sl_prev=0,sl_cur=0,sl_next=SLOTB;
  #define ROT() do{sl_prev=sl_cur;sl_cur=sl_next;sl_next=(sl_next==(NSLOT-1)*SLOTB)?0:sl_next+SLOTB;}while(0)
  DMA_K(2,2*SLOTB);
  WAIT_BAR(3);
  qkt(pA0,pA1,Kbase,qr,r32,hi,KAUG(0,0),KAUG(0,1),QAUG);asm volatile("s_nop 15\n\ts_nop 7":"+v"(pA0),"+v"(pA1));CMASK(pA0,pA1,0);
  START(pA0,pA1);
  _Pragma("unroll") for(int r=0;r<16;++r)pA1[r]=__builtin_amdgcn_exp2f(pA1[r]);
  WAIT_BAR(0);
  DMA_K(3,0);DMA_V(1,SLOTB);
  ROT();
  kload8(kf,kp0+sl_cur);
  WAIT_BAR(2);
  s16x4 vlo[8],vhi[8]; u32x4 pw0,pw1,pw2,pw3;
  #define PKW(P,B) cvtpk_s(P[B],P[B+1])
  #define PAF(k) __builtin_bit_cast(bf16x8,pw##k)
  #define VFR(i) (bf16x8){vlo[i][0],vlo[i][1],vlo[i][2],vlo[i][3],vhi[i][0],vhi[i][1],vhi[i][2],vhi[i][3]}
  #define PIN(x) asm volatile("":"+v"(x))
  #define MX3(a,b,c) __builtin_fmaxf(__builtin_fmaxf((a),(b)),(c))
  #define GAPA(MF,A0,A1,A2,A3,W0,W1,PW) do{ MF; sacc+=A0; sacc+=A1; sacc+=A2; sacc+=A3; PIN(sacc); W0; W1; PIN(PW); SBAR(); }while(0)
  #define EX(v) __builtin_amdgcn_exp2f(v)
  #define GAPB(MF,X,B) do{ MF; X[B]=EX(X[B]); X[B+1]=EX(X[B+1]); X[B+2]=EX(X[B+2]); X[B+3]=EX(X[B+3]); PIN(X); SBAR(); }while(0)
  #define VRD(i) do{ vlo[i]=vtr(vp_+(((i)>>2)*4096+((i)&3)*1024)); vhi[i]=vtr(vp_+(((i)>>2)*4096+((i)&3)*1024+512)); }while(0)
  #define KRD(G,j) do{ if(G){ kload2(kf,kp0+sl_next,j); SBAR(); } }while(0)
  #define STEP(C0,C1,P0,P1,t,GK,GV,GL) do{ SBAR(); \
    const lds_cptr vp_=vp0+sl_prev; const s16x4 ka0_=KAUG(t,0),ka1_=KAUG(t,1); \
    VRD(0); SBAR(); float sacc=(P0[0]+P0[1]); \
    GAPA(C0=__builtin_amdgcn_mfma_f32_32x32x16_bf16(kf[0],qr[0],zero16,0,0,0), P0[2],P0[3],P0[4],P0[5],     pw0[0]=PKW(P0,0), pw0[1]=PKW(P0,2), pw0); \
    VRD(4); SBAR(); GAPA(C1=__builtin_amdgcn_mfma_f32_32x32x16_bf16(kf[1],qr[0],zero16,0,0,0), P0[6],P0[7],P0[8],P0[9],     pw0[2]=PKW(P0,4), pw0[3]=PKW(P0,6), pw0); \
    VRD(1); SBAR(); GAPA(C0=__builtin_amdgcn_mfma_f32_32x32x16_bf16(kf[2],qr[1],C0,0,0,0),   P0[10],P0[11],P0[12],P0[13], pw1[0]=PKW(P0,8), pw1[1]=PKW(P0,10), pw1); \
    VRD(5); SBAR(); GAPA(C1=__builtin_amdgcn_mfma_f32_32x32x16_bf16(kf[3],qr[1],C1,0,0,0),   P0[14],P0[15],P1[0],P1[1],   pw1[2]=PKW(P0,12),pw1[3]=PKW(P0,14), pw1); \
    VRD(2); SBAR(); GAPA(C0=__builtin_amdgcn_mfma_f32_32x32x16_bf16(kf[4],qr[2],C0,0,0,0),   P1[2],P1[3],P1[4],P1[5],     pw2[0]=PKW(P1,0), pw2[1]=PKW(P1,2), pw2); \
    VRD(6); SBAR(); GAPA(C1=__builtin_amdgcn_mfma_f32_32x32x16_bf16(kf[5],qr[2],C1,0,0,0),   P1[6],P1[7],P1[8],P1[9],     pw2[2]=PKW(P1,4), pw2[3]=PKW(P1,6), pw2); \
    VRD(3); SBAR(); GAPA(C0=__builtin_amdgcn_mfma_f32_32x32x16_bf16(kf[6],qr[3],C0,0,0,0),   P1[10],P1[11],P1[12],P1[13], pw3[0]=PKW(P1,8), pw3[1]=PKW(P1,10), pw3); \
    VRD(7); SBAR(); GAPA(C1=__builtin_amdgcn_mfma_f32_32x32x16_bf16(kf[7],qr[3],C1,0,0,0),   P1[14],P1[15],0.f,0.f,       pw3[2]=PKW(P1,12),pw3[3]=PKW(P1,14), pw3); \
    C0=__builtin_amdgcn_mfma_f32_32x32x8bf16_1k(ka0_,QAUG,C0,0,0,0); C1=__builtin_amdgcn_mfma_f32_32x32x8bf16_1k(ka1_,QAUG,C1,0,0,0); \
    l_reg+=sacc; \
    if(GK){DMA_K((t)+3,sl_cur);} if(GV){DMA_V((t)+1,sl_next);} \
    CMASK(C0,C1,t); \
    { float a=MX3(C0[0],C0[1],C1[0]),b=MX3(C0[2],C0[3],C1[1]); a=MX3(a,C1[2],C1[3]); \
      _Pragma("unroll") for(int r=4;r<16;r+=4){a=MX3(a,C0[r],C0[r+1]);b=MX3(b,C0[r+2],C0[r+3]);a=MX3(a,C1[r],C1[r+1]);b=MX3(b,C1[r+2],C1[r+3]);} \
      float rm=__builtin_fmaxf(a,b); { auto rr=__builtin_amdgcn_permlane32_swap(__float_as_uint(rm),__float_as_uint(rm),false,false); rm=__builtin_fmaxf(__uint_as_float(rr[0]),__uint_as_float(rr[1])); } \
      resc=false; \
      if(__builtin_expect(__any(rm>(float)THRL),0)){ const float dl=__builtin_fmaxf(rm,0.f); mhat+=dl; \
        _Pragma("unroll") for(int r=0;r<16;++r){C0[r]-=dl;C1[r]-=dl;} \
        SETQ(); \
        const float f=__builtin_amdgcn_exp2f(-dl); l_reg*=f; if(hi==0)wsf[r32]=f; resc=true; } } \
    SBAR(); \
    GAPB(o[0]=__builtin_amdgcn_mfma_f32_32x32x16_bf16(PAF(0),VFR(0),o[0],0,0,0), C0,0); \
    GAPB(o[1]=__builtin_amdgcn_mfma_f32_32x32x16_bf16(PAF(0),VFR(4),o[1],0,0,0), C0,4); \
    KRD(GL,0); GAPB(o[0]=__builtin_amdgcn_mfma_f32_32x32x16_bf16(PAF(1),VFR(1),o[0],0,0,0), C0,8); \
    KRD(GL,1); GAPB(o[1]=__builtin_amdgcn_mfma_f32_32x32x16_bf16(PAF(1),VFR(5),o[1],0,0,0), C0,12); \
    KRD(GL,2); GAPB(o[0]=__builtin_amdgcn_mfma_f32_32x32x16_bf16(PAF(2),VFR(2),o[0],0,0,0), C1,0); \
    KRD(GL,3); GAPB(o[1]=__builtin_amdgcn_mfma_f32_32x32x16_bf16(PAF(2),VFR(6),o[1],0,0,0), C1,4); \
    GAPB(o[0]=__builtin_amdgcn_mfma_f32_32x32x16_bf16(PAF(3),VFR(3),o[0],0,0,0), C1,8); \
    GAPB(o[1]=__builtin_amdgcn_mfma_f32_32x32x16_bf16(PAF(3),VFR(7),o[1],0,0,0), C1,12); \
    }while(0)
  int t=1;
  #undef CMASK
  #define CMASK(P0,P1,t) do{}while(0)
  for(;t+5<NT;t+=2){
    STEP(pB0,pB1,pA0,pA1,t,true,true,true);     WAIT_BAR(2); RESC(); ROT();
    STEP(pA0,pA1,pB0,pB1,t+1,true,true,true);   WAIT_BAR(2); RESC(); ROT();
  }
  #undef CMASK
  #define CMASK(P0,P1,t) do{int jb_=(t)-(NT-4); if(jb_>=0)cmask(P0,P1,jb_,qrel,hi);}while(0)
  #define ENDW(tt) do{ if((tt)+3<NT){WAIT_BAR(2);} else if((tt)+2<NT){WAIT_BAR(1);} else {WAIT_BAR(0);} }while(0)
  for(;t+1<NT;t+=2){
    STEP(pB0,pB1,pA0,pA1,t,(t+3<NT),(t+1<NT),(t+1<NT));       ENDW(t);   RESC(); ROT();
    STEP(pA0,pA1,pB0,pB1,t+1,(t+4<NT),(t+2<NT),(t+2<NT));     ENDW(t+1); RESC(); ROT();
  }
  #define DRAIN(P0,P1,slot) do{ float sacc=P0[0]+P0[1]; _Pragma("unroll") for(int r=2;r<16;++r)sacc+=P0[r]; _Pragma("unroll") for(int r=0;r<16;++r)sacc+=P1[r]; l_reg+=sacc; \
    pw0=(u32x4){PKW(P0,0),PKW(P0,2),PKW(P0,4),PKW(P0,6)};pw1=(u32x4){PKW(P0,8),PKW(P0,10),PKW(P0,12),PKW(P0,14)};pw2=(u32x4){PKW(P1,0),PKW(P1,2),PKW(P1,4),PKW(P1,6)};pw3=(u32x4){PKW(P1,8),PKW(P1,10),PKW(P1,12),PKW(P1,14)}; \
    SBAR(); pv(o,vb0+(slot),PAF(0),PAF(1),PAF(2),PAF(3)); }while(0)
  if(wid>=6){ STEP(pB0,pB1,pA0,pA1,NT-1,false,false,false); RESC(); DRAIN(pB0,pB1,sl_cur); }
  else if(wid>=4){ DRAIN(pA0,pA1,sl_prev); }
  #undef DRAIN
  #undef PKW
  #undef PAF
  #undef VFR
  #undef PIN
  #undef MX3
  #undef GAPA
  #undef GAPB
  #undef EX
  #undef VRD
  #undef KRD
  #undef STEP
  #undef ENDW
  {auto rr=__builtin_amdgcn_permlane32_swap(__float_as_uint(l_reg),__float_as_uint(l_reg),false,false);l_reg=__uint_as_float(rr[0])+__uint_as_float(rr[1]);}
  if(hi==0)wsf[32+r32]=l_reg;asm volatile("s_waitcnt lgkmcnt(0)":::"memory");
  float rli[16];
  #pragma unroll
  for(int r=0;r<16;++r)rli[r]=__builtin_amdgcn_rcpf(wsf[32+crow(r,hi)]);
  bf16*Ow=O+(rowbase+q0+wid*QBLK)*DM+h*D; const bf16*Gw=GF+(rowbase+q0+wid*QBLK)*DM+h*D;
  u32x4 gv[4];
  #pragma unroll
  for(int i=0;i<4;++i){const int row=i*8+(lane>>3),ch=lane&7; gv[i]=*(const u32x4*)(Gw+(long)row*DM+ch*8);}
  { bf16*stg=(bf16*)(shm+LDS_OST)+wid*2048;
    #pragma unroll
    for(int r=0;r<16;++r){const int orow=crow(r,hi);
      #pragma unroll
      for(int d0=0;d0<2;++d0)stg[orow*64+d0*32+r32]=__float2bfloat16(o[d0][r]*rli[r]);}
    asm volatile("s_waitcnt lgkmcnt(0)":::"memory");
    #pragma unroll
    for(int i=0;i<4;++i){const int row=i*8+(lane>>3),ch=lane&7; u32x4 v=*(const u32x4*)(stg+row*64+ch*8);
      #pragma unroll
      for(int j=0;j<4;++j){const unsigned a=v[j],g=gv[i][j]; v[j]=cvtpk_s(__uint_as_float(a<<16)*__uint_as_float(g<<16),__uint_as_float(a&0xffff0000u)*__uint_as_float(g&0xffff0000u));}
      ATTN_STORE16(Ow+(long)row*DM+ch*8,v);} }
  asm volatile("s_waitcnt lgkmcnt(0)\n\ts_barrier":::"memory");
  #undef DMA_K
  #undef KAUG
  #undef QAUG
  #undef SETQ
  #undef DMA_V
  #undef CMASK
  #undef START
  #undef RESC
  #undef ROT
}
constexpr int ATTN_LDS_BYTES=LDS_BYTES;
struct AttnTensors { const bf16* Q; const bf16* K; const bf16* V; bf16* O; const bf16* GF; };
#undef SBAR
#undef WAIT_BAR
}
constexpr int NWAVES = 8;
constexpr int BATCH = 16, SEQ = 2048, DMODEL = 1024, NH = 16, HD = 64, CK = 31;
constexpr int M = BATCH * SEQ;
constexpr int IN_COLS = 7184;
constexpr int O_Q = 0, O_K = 1024, O_V = 2048, O_F = 3072, O_GF = 3088, O_GLU = 4112, O_GC = 6160;
constexpr int N1 = 28 * 256;
constexpr int K2 = 2048;
constexpr size_t MiB = 1u << 20;
constexpr int CW_CONV = 3520;
constexpr size_t WS_CTL = 0, CTL_ZERO_BYTES = 16384;
constexpr size_t WS_BT1 = 2 * MiB;
constexpr size_t WS_BT2 = 18 * MiB;
constexpr size_t WS_RS = 26 * MiB;
constexpr size_t WS_LF = 24 * MiB;
constexpr size_t WS_XN = 32 * MiB;
constexpr size_t WS_Q = 96 * MiB, WS_K = 160 * MiB, WS_V = 224 * MiB, WS_GF = 288 * MiB, WS_U = 352 * MiB, WS_GC = 416 * MiB, WS_END = 480 * MiB;
constexpr int RING_BYTES = 131072;
constexpr int LDS_BYTES = 151552;
constexpr int BT_OFF = 98304, BT_BYTES = 32768, WT_OFF = BT_OFF + BT_BYTES;
constexpr int MISC_OFF = WT_OFF + 128;
constexpr int ESTG_OFF = WT_OFF + 512, ESTG_BYTES = 8 * 2304;
static_assert(ESTG_OFF + ESTG_BYTES <= LDS_BYTES, "LDS map");
static_assert(attn_body::ATTN_LDS_BYTES <= BT_OFF && MISC_OFF + 64 <= LDS_BYTES, "LDS map");

#define GAS __attribute__((address_space(1)))
#define LAS __attribute__((address_space(3)))
typedef unsigned short bf16;
typedef unsigned v4u __attribute__((ext_vector_type(4)));
typedef unsigned v2u __attribute__((ext_vector_type(2)));
typedef float f32x4 __attribute__((ext_vector_type(4)));
typedef float f32x2 __attribute__((ext_vector_type(2)));
__device__ __forceinline__ unsigned f2bf(float f) { unsigned u = __builtin_bit_cast(unsigned, f); return (u + 0x7fffu + ((u >> 16) & 1u)) >> 16; }
__device__ __forceinline__ unsigned pk2(float lo, float hi) { return f2bf(lo) | (f2bf(hi) << 16); }
__device__ __forceinline__ float bf_lo(unsigned w) { return __uint_as_float(w << 16); }
__device__ __forceinline__ float bf_hi(unsigned w) { return __uint_as_float(w & 0xffff0000u); }
__device__ __forceinline__ float wave_sum(float v) {
#pragma unroll
    for (int o = 1; o < 64; o <<= 1) v += __shfl_xor(v, o);
    return v;
}
struct Args { const float* in[11]; float* out; unsigned char* ws; int ph_lo, ph_hi; };
typedef const __attribute__((address_space(4))) Args* KArgs;

#define RLX_AGENT __ATOMIC_RELAXED, __HIP_MEMORY_SCOPE_AGENT
#define LDS_WAIT() asm volatile("s_waitcnt lgkmcnt(0)" ::: "memory")
#define VM_WAIT() asm volatile("s_waitcnt vmcnt(0)" ::: "memory")
#define XB_TMO      128
#define XB_XCNT(j)  (256  + 64 * (j))
#define XB_XSUB(j)  (1280 + 64 * (j))
#define XB_XGEN(j)  (2304 + 64 * (j))
#define XB_TOP      3328
#define XB_TOPGEN   3392
#define XCD_BAR_WORDS 3456
#define XB_SPIN_CAP (1u << 18)

__device__ __forceinline__ unsigned xb_ld(unsigned* p)              { return __hip_atomic_load(p, __ATOMIC_RELAXED, __HIP_MEMORY_SCOPE_AGENT); }
__device__ __forceinline__ unsigned xb_add(unsigned* p, unsigned v) { return __hip_atomic_fetch_add(p, v, __ATOMIC_RELAXED, __HIP_MEMORY_SCOPE_AGENT); }
__device__ __forceinline__ unsigned xb_xcc_id() { return (unsigned)__builtin_amdgcn_s_getreg((3 << 11) | 20) & 0xFu; }
#define XB_SPIN(cond, bar) do { unsigned _sp = 0; while (cond) { __builtin_amdgcn_s_sleep(1); \
    if ((++_sp & 255u) == 0u) { if (xb_ld(&(bar)[XB_TMO])) break; if (_sp > XB_SPIN_CAP) { atomicAdd(&(bar)[XB_TMO], 1u); break; } } } } while (0)

struct XcdBarrier {
    unsigned* bar; unsigned x;
    volatile LAS unsigned* st;
};

__device__ __forceinline__ XcdBarrier xcd_barrier_post(unsigned* bar, volatile LAS unsigned* st) {
    XcdBarrier b; b.bar = bar; b.x = xb_xcc_id(); b.st = st;
    if (threadIdx.x == 0) (void)xb_add(&bar[XB_XCNT(b.x)], 1u);
    return b;
}
__device__ __forceinline__ void xcd_barrier_complete(unsigned* bar, unsigned x, unsigned& nloc, unsigned& nx) {
    const unsigned G = gridDim.x * gridDim.y * gridDim.z;
    unsigned sum, cnt, mine, sp = 0u;
    for (;;) {
        sum = 0u; cnt = 0u; mine = 0u;
#pragma unroll
        for (unsigned j = 0; j < 16; ++j) { const unsigned c = xb_ld(&bar[XB_XCNT(j)]); sum += c; cnt += (c > 0u) ? 1u : 0u; mine = (j == x) ? c : mine; }
        if (sum == G) break;
        __builtin_amdgcn_s_sleep(1);
        if ((++sp & 255u) == 0u) { if (xb_ld(&bar[XB_TMO])) break; if (sp > XB_SPIN_CAP) { atomicAdd(&bar[XB_TMO], 1u); break; } }
    }
    nloc = mine > 0u ? mine : 1u; nx = cnt > 0u ? cnt : 1u;
}

__device__ __forceinline__ void xcd_barrier(const XcdBarrier& b) {
    asm volatile("s_waitcnt vmcnt(0)" ::: "memory");
    __syncthreads();
    if (threadIdx.x == 0) {
        unsigned* bar = b.bar;
        __builtin_amdgcn_s_waitcnt(0);
        unsigned nloc = b.st[0], nx = b.st[1];
        if (nloc == 0u) { xcd_barrier_complete(bar, b.x, nloc, nx); b.st[0] = nloc; b.st[1] = nx; }
        const unsigned old = xb_add(&bar[XB_XSUB(b.x)], 1u);
        const unsigned gen = old / nloc;
        if (old + 1u == (gen + 1u) * nloc) {
            __builtin_amdgcn_fence(__ATOMIC_RELEASE, "agent");
            asm volatile("s_waitcnt vmcnt(0)" ::: "memory");
            const unsigned og = xb_add(&bar[XB_TOP], 1u);
            const unsigned tg = og / nx;
            if (og + 1u == (tg + 1u) * nx) xb_add(&bar[XB_TOPGEN], 1u);
            else XB_SPIN(xb_ld(&bar[XB_TOPGEN]) == tg, bar);
            __builtin_amdgcn_fence(__ATOMIC_ACQUIRE, "agent");
            xb_add(&bar[XB_XGEN(b.x)], 1u);
            asm volatile("s_waitcnt vmcnt(0)" ::: "memory");
        } else {
            XB_SPIN(xb_ld(&bar[XB_XGEN(b.x)]) == gen, bar);
            __builtin_amdgcn_fence(__ATOMIC_ACQUIRE, "agent");
            asm volatile("s_waitcnt vmcnt(0)" ::: "memory");
        }
    }
    __syncthreads();
}

__device__ __forceinline__ void p0_transpose_item(const float* __restrict__ W, int ldw, int src_col0, const float* __restrict__ gk, bool use_g, bf16* __restrict__ WT, int K, int dst_row0, int kb, LAS float* scr, int lane) {
    const int k0 = 64 * kb, c = lane & 31, kh = lane >> 5;
    const float* __restrict__ wp = W + (size_t)(k0 + kh) * ldw + src_col0 + c; const float* __restrict__ gp = gk + ((k0 + kh) & (DMODEL - 1));
    float v[32], gg[32];
#pragma unroll
    for (int i = 0; i < 32; ++i) { v[i] = wp[(size_t)(2 * i) * ldw]; gg[i] = gp[2 * i]; }
    asm volatile("" ::: "memory");
#pragma unroll
    for (int i = 0; i < 32; ++i) scr[(2 * i + kh) * 33 + c] = v[i] * (use_g ? gg[i] : 1.0f);
    asm volatile("s_waitcnt lgkmcnt(0)" ::: "memory");
    const int c8 = lane & 7;
#pragma unroll
    for (int j = 0; j < 4; ++j) { const int n = (lane >> 3) + 8 * j; const LAS float* s = scr + (8 * c8) * 33 + n;
        v4u o; o.x = pk2(s[0 * 33], s[1 * 33]); o.y = pk2(s[2 * 33], s[3 * 33]); o.z = pk2(s[4 * 33], s[5 * 33]); o.w = pk2(s[6 * 33], s[7 * 33]);
        *(v4u*)(WT + (size_t)(dst_row0 + n) * K + k0 + 8 * c8) = o; }
    asm volatile("s_waitcnt lgkmcnt(0)" ::: "memory");
}
__device__ __forceinline__ int bt1_src(int rg) {
    const int pn = rg >> 3, tcg = rg & 7, bj = tcg >> 2, wc = tcg & 3;
    if (pn < 4)  return O_Q + 256 * pn + 64 * wc + 32 * bj;
    if (pn < 8)  return O_K + 256 * (pn - 4) + 64 * wc + 32 * bj;
    if (pn < 12) return O_V + 256 * (pn - 8) + 64 * wc + 32 * bj;
    if (pn < 16) return O_GF + 256 * (pn - 12) + 64 * wc + 32 * bj;
    if (pn < 24) return O_GLU + 1024 * bj + 128 * (pn - 16) + 32 * wc;
    return O_GC + 256 * (pn - 24) + 64 * wc + 32 * bj;
}
__device__ __forceinline__ void p0_prologue(KArgs Ap, LAS unsigned char* lds, int vcu, int G, int tid, int wave, int lane) {
    LAS float* scr = (LAS float*)(lds + wave * 16384);
    const int gw = vcu * NWAVES + wave, NGW = G * NWAVES;
    const float* w_in = Ap->in[2]; const float* w_out = Ap->in[10]; const float* ng = Ap->in[1]; unsigned char* ws = Ap->ws;
    bf16* BT1 = (bf16*)(ws + WS_BT1); bf16* BT2 = (bf16*)(ws + WS_BT2);
    constexpr int I1 = (N1 / 32) * 16, I2 = (DMODEL / 32) * (K2 / 64);
    for (int it = gw; it < I1 + I2; it += NGW) {
        if (it < I1) { const int rg = it >> 4, kb = it & 15; p0_transpose_item(w_in, IN_COLS, bt1_src(rg), ng, true, BT1, DMODEL, rg * 32, kb, scr, lane); }
        else { const int r = it - I1, n32 = r >> 5, kb = r & 31; p0_transpose_item(w_out, DMODEL, n32 * 32, ng, false, BT2, K2, n32 * 32, kb, scr, lane); }
    }
    __syncthreads();
    LAS v4u* wf = (LAS v4u*)lds;
    for (int e = tid; e < 32 * 64; e += NWAVES * 64) { const int kk = e >> 6, l = e & 63, kb = 32 * kk + 8 * (l >> 4), hd = l & 15; float v[8];
#pragma unroll
        for (int i = 0; i < 8; ++i) v[i] = w_in[(size_t)(kb + i) * IN_COLS + O_F + hd] * ng[kb + i];
        wf[e] = (v4u){pk2(v[0], v[1]), pk2(v[2], v[3]), pk2(v[4], v[5]), pk2(v[6], v[7])}; }
    __syncthreads();
    const float* x = Ap->in[0]; const float* bfg = Ap->in[3]; bf16* XN = (bf16*)(ws + WS_XN); float* RS = (float*)(ws + WS_RS); float* LF = (float*)(ws + WS_LF);
    const int fr = lane & 15, fq = lane >> 4;
    for (int grp = gw; grp < M / 16; grp += NGW) {
        const int r0 = grp * 16;
        const f32x4* __restrict__ xp = (const f32x4*)(x + (size_t)(r0 + fr) * DMODEL + 8 * fq); v4u* __restrict__ op = (v4u*)(XN + (size_t)(r0 + fr) * DMODEL + 8 * fq);
        pg8::f32x4 acc = {0.f, 0.f, 0.f, 0.f}; float ss = 0.f;
        f32x4 cur[8][2], nxt[8][2];
#pragma unroll
        for (int j = 0; j < 8; ++j) { cur[j][0] = __builtin_nontemporal_load(xp + 8 * j); cur[j][1] = __builtin_nontemporal_load(xp + 8 * j + 1); }
#pragma unroll
        for (int kb8 = 0; kb8 < 32; kb8 += 8) {
            if (kb8 + 8 < 32) {
#pragma unroll
                for (int j = 0; j < 8; ++j) { nxt[j][0] = __builtin_nontemporal_load(xp + 8 * (kb8 + 8 + j)); nxt[j][1] = __builtin_nontemporal_load(xp + 8 * (kb8 + 8 + j) + 1); }
            }
            asm volatile("" ::: "memory");
#pragma unroll
            for (int j = 0; j < 8; ++j) { const int kk = kb8 + j; const f32x4 a0 = cur[j][0], a1 = cur[j][1];
                ss += (a0.x * a0.x + a0.y * a0.y) + (a0.z * a0.z + a0.w * a0.w) + (a1.x * a1.x + a1.y * a1.y) + (a1.z * a1.z + a1.w * a1.w);
                const v4u av = {attn_body::cvtpk_s(a0.x, a0.y), attn_body::cvtpk_s(a0.z, a0.w), attn_body::cvtpk_s(a1.x, a1.y), attn_body::cvtpk_s(a1.z, a1.w)};
                op[4 * kk] = av;
                acc = __builtin_amdgcn_mfma_f32_16x16x32_bf16(__builtin_bit_cast(pg8::bf16x8, av), __builtin_bit_cast(pg8::bf16x8, wf[kk * 64 + lane]), acc, 0, 0, 0); }
            asm volatile("" ::: "memory");
#pragma unroll
            for (int j = 0; j < 8; ++j) { cur[j][0] = nxt[j][0]; cur[j][1] = nxt[j][1]; }
        }
        ss += __shfl_xor(ss, 16); ss += __shfl_xor(ss, 32);
        const float rs = 1.0f / sqrtf(ss * (1.f / DMODEL) + pg8::kEPS);
        if (fq == 0) RS[r0 + fr] = rs;
        const float bb = bfg[fr];
#pragma unroll
        for (int e = 0; e < 4; ++e) { const int r = 4 * fq + e; const float z = __shfl(rs, r) * acc[e] + bb;
            LF[(size_t)(r0 + r) * 16 + fr] = fminf(z, 0.f) - log1pf(expf(-fabsf(z))); }
    }
}

__device__ __forceinline__ f32x2 unpk(unsigned w) { return (f32x2){bf_lo(w), bf_hi(w)}; }
__device__ __forceinline__ void conv_phase(KArgs Ap, LAS unsigned char* lds, int vcu, int G, int tid, int wave, int lane, size_t out_off) {
    (void)vcu; (void)G;
    LAS float* red = (LAS float*)lds;
    LAS f32x2* fin = (LAS f32x2*)(lds + 1024);
    const int c0 = 2 * tid;
    const float* cw = Ap->in[6]; unsigned char* ws = Ap->ws;
    f32x2 w[CK];
#pragma unroll
    for (int j = 0; j < CK; ++j) w[j] = *(const f32x2*)(cw + j * 1024 + c0);
    const f32x2 cb = *(const f32x2*)(Ap->in[7] + c0), lg = *(const f32x2*)(Ap->in[8] + c0), lb = *(const f32x2*)(Ap->in[9] + c0);
    const bf16* U = (const bf16*)(ws + WS_U); bf16* GC = (bf16*)(ws + WS_GC);
    unsigned* ctr = (unsigned*)(ws + WS_CTL) + CW_CONV; volatile LAS int* ubox = (volatile LAS int*)(lds + 2048);
    for (;;) {
        if (tid == 0) ubox[0] = (int)__hip_atomic_fetch_add(ctr, 1u, __ATOMIC_RELAXED, __HIP_MEMORY_SCOPE_AGENT);
        __syncthreads();
        const int unit = ubox[0];
        __syncthreads();
        if (unit >= M / 64) break;
        const int row0 = unit * 64, t0 = row0 & (SEQ - 1);
        const bf16* Up = U + (size_t)row0 * 1024 + c0; bf16* Gp = GC + (size_t)row0 * 1024 + c0; bf16* Op = (bf16*)(ws + out_off) + (size_t)row0 * 1024 + c0;
        f32x2 win[38];
#pragma unroll
        for (int i = 0; i < 30; ++i) { const unsigned raw = (t0 - 30 + i >= 0) ? *(const unsigned*)(Up + (long)(i - 30) * 1024) : 0u; win[i] = unpk(raw); }
        unsigned nx[8], nx2[8], gcn[8];
#pragma unroll
        for (int i = 0; i < 8; ++i) nx[i] = *(const unsigned*)(Up + (long)i * 1024);
#pragma unroll
        for (int i = 0; i < 8; ++i) nx2[i] = *(const unsigned*)(Up + (long)(8 + i) * 1024);
#pragma unroll
        for (int i = 0; i < 8; ++i) gcn[i] = *(const unsigned*)(Gp + (long)i * 1024);
#pragma unroll 1
        for (int ch = 0; ch < 8; ++ch) {
            unsigned gcr[8];
#pragma unroll
            for (int i = 0; i < 8; ++i) { win[30 + i] = unpk(nx[i]); nx[i] = nx2[i]; gcr[i] = gcn[i]; }
            { const int c2 = (ch + 2 < 8) ? ch + 2 : 7, c1 = (ch + 1 < 8) ? ch + 1 : 7;
#pragma unroll
              for (int i = 0; i < 8; ++i) nx2[i] = *(const unsigned*)(Up + (long)(c2 * 8 + i) * 1024);
#pragma unroll
              for (int i = 0; i < 8; ++i) gcn[i] = *(const unsigned*)(Gp + (long)(c1 * 8 + i) * 1024); }
            f32x2 y[8];
#pragma unroll
            for (int i = 0; i < 8; ++i) { f32x2 a = cb;
#pragma unroll
                for (int j = 0; j < CK; ++j) a += w[j] * win[i + j];
                y[i] = a; }
            float st[16];
#pragma unroll
            for (int i = 0; i < 8; ++i) { st[2 * i] = y[i].x + y[i].y; st[2 * i + 1] = y[i].x * y[i].x + y[i].y * y[i].y; }
            {
#pragma unroll
              for (int k = 0; k < 8; ++k) { const auto r = __builtin_amdgcn_permlane32_swap(__float_as_uint(st[k]), __float_as_uint(st[k + 8]), false, false); st[k] = __uint_as_float(r[0]) + __uint_as_float(r[1]); }
#pragma unroll
              for (int k = 0; k < 4; ++k) { const auto r = __builtin_amdgcn_permlane16_swap(__float_as_uint(st[k]), __float_as_uint(st[k + 4]), false, false); st[k] = __uint_as_float(r[0]) + __uint_as_float(r[1]); }
              const bool h3 = (lane & 8) != 0;
#pragma unroll
              for (int k = 0; k < 2; ++k) { const float send = h3 ? st[k] : st[k + 2], keep = h3 ? st[k + 2] : st[k]; st[k] = keep + __shfl_xor(send, 8); }
              const bool h2 = (lane & 4) != 0;
              { const float send = h2 ? st[0] : st[1], keep = h2 ? st[1] : st[0]; st[0] = keep + __shfl_xor(send, 4); }
              st[0] += __shfl_xor(st[0], 2); st[0] += __shfl_xor(st[0], 1); }
            const int pb = ch & 1;
            if ((lane & 3) == 0) red[(pb * 8 + wave) * 16 + ((lane >> 2) & 15)] = st[0];
            __syncthreads();
            if (tid < 8) { float s1 = 0.f, s2 = 0.f;
#pragma unroll
                for (int wv = 0; wv < 8; ++wv) { s1 += red[(pb * 8 + wv) * 16 + 2 * tid]; s2 += red[(pb * 8 + wv) * 16 + 2 * tid + 1]; }
                const float mu = s1 * (1.f / 1024.f), var = fmaxf(s2 * (1.f / 1024.f) - mu * mu, 0.f);
                fin[pb * 8 + tid] = (f32x2){mu, 1.0f / sqrtf(var + pg8::kEPS)}; }
            __syncthreads();
#pragma unroll
            for (int i = 0; i < 8; ++i) { const f32x2 ms = fin[pb * 8 + i]; const f32x2 a = lg * ms.y, b = lb - a * ms.x; const f32x2 z = y[i] * a + b; const f32x2 gg = unpk(gcr[i]);
                const f32x2 t = z * (-pg8::kLOG2E); f32x2 d; d.x = __builtin_amdgcn_exp2f(t.x); d.y = __builtin_amdgcn_exp2f(t.y); d = d + 1.0f;
                f32x2 r; r.x = __builtin_amdgcn_rcpf(d.x); r.y = __builtin_amdgcn_rcpf(d.y);
                const f32x2 o = (z * r) * gg;
                *(unsigned*)(Op + (long)(ch * 8 + i) * 1024) = pg8::cvt_pk_bf16(o.x, o.y); }
#pragma unroll
            for (int i = 0; i < 30; ++i) asm("v_pk_mov_b32 %0, %1, %1 op_sel:[0,1]" : "=v"(win[i]) : "v"(win[i + 8]));
        }
    }
    __syncthreads();
}

__device__ __forceinline__ void build_bias_table(const float* LF, int bh, LAS unsigned char* lds, int tid, int wave, int lane) {
    LAS v4u* tab = (LAS v4u*)(lds + BT_OFF); LAS float* wtot = (LAS float*)(lds + WT_OFF);
    const int b = bh >> 4, h = bh & 15;
    const float* lf = LF + (size_t)b * SEQ * 16 + h;
    const int t0 = 4 * tid; float v[4];
#pragma unroll
    for (int i = 0; i < 4; ++i) v[i] = lf[(size_t)(t0 + i) * 16];
    v[1] += v[0]; v[2] += v[1]; v[3] += v[2];
    const float tot = v[3]; float inc = tot;
#pragma unroll
    for (int o = 1; o < 64; o <<= 1) { const float n = __shfl_up(inc, o); if (lane >= o) inc += n; }
    if (lane == 63) wtot[wave] = inc;
    __syncthreads();
    float off = inc - tot;
    for (int wv = 0; wv < wave; ++wv) off += wtot[wv];
#pragma unroll
    for (int i = 0; i < 4; ++i) { const float bias = -(v[i] + off) * pg8::kLOG2E;
        const unsigned b1 = f2bf(bias); const float r1 = bias - __uint_as_float(b1 << 16);
        const unsigned b2 = f2bf(r1);   const float r2 = r1 - __uint_as_float(b2 << 16);
        const unsigned b3 = f2bf(r2);
        tab[t0 + i] = (v4u){b1 | (b2 << 16), b3 | 0x3F800000u, 0x3F803F80u, 0u}; }
    __syncthreads();
}
__global__ void __launch_bounds__(NWAVES * 64, 2) skel_fwd(Args args) {
    extern __shared__ __attribute__((aligned(16))) unsigned char lds_raw[];
    LAS unsigned char* lds = (LAS unsigned char*)lds_raw;
    const int G = gridDim.x, bx = blockIdx.x, vcu = (G % 8 == 0) ? (bx % 8) * (G / 8) + bx / 8 : bx;
#define PHASE_IDS() int tid = threadIdx.x; asm volatile("" : "+v"(tid)); const int lane = tid & 63, wave = __builtin_amdgcn_readfirstlane(tid >> 6); (void)lane; (void)wave
#define KARGS() ({ KArgs k_ = (KArgs)__builtin_amdgcn_kernarg_segment_ptr(); asm volatile("" : "+s"(k_)); k_; })
#if MK_N_LAUNCHES == 1
#define IN(k) true
#define GRID_BAR() xcd_barrier(bar)
#else
    const int lo = args.ph_lo, hi = args.ph_hi;
#define IN(k) (lo <= (k) && (k) < hi)
#define GRID_BAR() do {} while (0)
#endif

#if MK_N_LAUNCHES == 1
    if (threadIdx.x < 2) ((volatile LAS unsigned*)(lds + MISC_OFF))[threadIdx.x] = 0u;
    __syncthreads();
    XcdBarrier bar = xcd_barrier_post((unsigned*)(KARGS()->ws + WS_CTL), (volatile LAS unsigned*)(lds + MISC_OFF));
    if (KARGS()->ph_lo < 0) cg::this_grid().sync();
#endif
    if (IN(0)) { PHASE_IDS(); int nrep0 = (MK_PROBE == 1) ? 2 : 1; asm volatile("" : "+s"(nrep0));
#pragma unroll 1
        for (int r = 0; r < nrep0; ++r) { p0_prologue(KARGS(), lds, vcu, G, tid, wave, lane); __syncthreads(); }

 if (IN(1)) GRID_BAR(); }

    if (IN(1)) {
        KArgs Ap = KARGS(); unsigned char* ws = Ap->ws;
        pg8::Gemm g{(const bf16*)(ws + WS_XN), (const bf16*)(ws + WS_BT1), M, N1, DMODEL, DMODEL, 1 << 30, 0l}; pg8::StaticOrder S; S.init(M, N1, G, bx);
        pg8::Epi1 E{(bf16*)(ws + WS_Q), (const float*)(ws + WS_RS), Ap->in[4], Ap->in[5], lds + ESTG_OFF};
        int nrep1 = (MK_PROBE == 2) ? 2 : 1; asm volatile("" : "+s"(nrep1));
#pragma unroll 1
        for (int r = 0; r < nrep1; ++r) { pg8::gemm_phase<pg8::Epi1, pg8::StaticOrder, true, true>(lds, g, S, E); __syncthreads(); }
#if MK_N_LAUNCHES == 1
        { PHASE_IDS(); build_bias_table((const float*)(ws + WS_LF), vcu % (BATCH * NH), lds, tid, wave, lane); }
#endif
        if (IN(2)) GRID_BAR();
    }

    if (IN(2)) {
        { PHASE_IDS();
        unsigned char* ws = KARGS()->ws;
        const attn_body::bf16* QB = (const attn_body::bf16*)(ws + WS_Q);
        int cur_bh = (MK_N_LAUNCHES == 1) ? vcu % (BATCH * NH) : -1;
        int pass0 = (MK_PROBE == 4) ? 0 : 1; asm volatile("" : "+s"(pass0));
#pragma unroll 1
        for (int pass = pass0; pass < 2; ++pass)
        for (int L = vcu; L < BATCH * NH * (SEQ / 256); L += G) {
            const int bh = L % (BATCH * NH), qb = L / (BATCH * NH);
            if (bh != cur_bh) { build_bias_table((const float*)(ws + WS_LF), bh, lds, tid, wave, lane); cur_bh = bh; }
#ifndef NO_ATTN
            attn_body::attn_unit<96>(bh >> 4, bh & 15, qb, QB, QB + pg8::Epi1::ZS, QB + 2 * pg8::Epi1::ZS, pass ? (attn_body::bf16*)QB : (attn_body::bf16*)(ws + WS_XN), QB + 3 * pg8::Epi1::ZS, (char*)lds_raw, (attn_body::lds_cptr)(lds + BT_OFF));
#endif
        }
        }
        __syncthreads();
#ifndef NO_CONV
        { PHASE_IDS(); conv_phase(KARGS(), lds, vcu, G, tid, wave, lane, WS_GC); }
#endif
        if (IN(3)) GRID_BAR();
    }

    if (IN(3)) {
        KArgs Ap = KARGS(); unsigned char* ws = Ap->ws;
        pg8::Gemm g{(const bf16*)(ws + WS_Q), (const bf16*)(ws + WS_BT2), M, DMODEL, K2, DMODEL, 16, (long)(WS_GC - WS_Q) - 16l * 128l}; pg8::StaticOrder S; S.init(M, DMODEL, G, bx);
        pg8::Epi2 E{Ap->in[0], Ap->out, lds + ESTG_OFF};
        int nrep3 = (MK_PROBE == 5) ? 2 : 1; asm volatile("" : "+s"(nrep3));
#pragma unroll 1
        for (int r = 0; r < nrep3; ++r) { pg8::gemm_phase<pg8::Epi2, pg8::StaticOrder, true, true>(lds, g, S, E); __syncthreads(); }
    }
#undef KARGS
#undef IN
}

extern "C" void kernel_launch(void* const* d_in, const int* in_sizes, int n_in, void* d_out, int out_size, void* d_ws, size_t ws_size, hipStream_t stream) {
    static int grid = 0;
    if (grid == 0) {
        if (n_in != 11 || in_sizes[0] != M * DMODEL || out_size != M * DMODEL || ws_size < WS_END) { fprintf(stderr, "kernel_launch: shape/workspace mismatch (n_in %d, in0 %d, out %d, ws %zu)\n", n_in, n_in > 0 ? in_sizes[0] : -1, out_size, ws_size); grid = -1; return; }
        int dev = 0, cus = 0, per_cu = 0;
        if (hipGetDevice(&dev) != hipSuccess || hipDeviceGetAttribute(&cus, hipDeviceAttributeMultiprocessorCount, dev) != hipSuccess) { grid = -1; return; }
        if (hipFuncSetAttribute((const void*)skel_fwd, hipFuncAttributeMaxDynamicSharedMemorySize, LDS_BYTES) != hipSuccess) { fprintf(stderr, "kernel_launch: hipFuncSetAttribute failed\n"); grid = -1; return; }
        if (hipOccupancyMaxActiveBlocksPerMultiprocessor(&per_cu, (const void*)skel_fwd, NWAVES * 64, LDS_BYTES) != hipSuccess || per_cu < 1) { fprintf(stderr, "kernel_launch: occupancy query says %d blocks per CU\n", per_cu); per_cu = 1; }
        (void)hipGetLastError();
        grid = cus;
    }
    if (grid < 0) return;
    if (hipMemsetAsync((char*)d_ws + WS_CTL, 0, CTL_ZERO_BYTES, stream) != hipSuccess) { fprintf(stderr, "kernel_launch: hipMemsetAsync failed\n"); return; }
    Args a{};
    for (int i = 0; i < 11; ++i) a.in[i] = (const float*)d_in[i];
    a.out = (float*)d_out; a.ws = (unsigned char*)d_ws;
#if MK_N_LAUNCHES == 1
    a.ph_lo = 0; a.ph_hi = 4;
    void* kargs[] = {&a};
    hipError_t e = hipLaunchCooperativeKernel((const void*)skel_fwd, dim3(grid), dim3(NWAVES * 64), kargs, LDS_BYTES, stream);
    if (e != hipSuccess) fprintf(stderr, "cooperative launch failed: %s (grid %d)\n", hipGetErrorString(e), grid);
#else
    for (int p = 0; p < 4; ++p) { a.ph_lo = p; a.ph_hi = p + 1; hipLaunchKernelGGL(skel_fwd, dim3(grid), dim3(NWAVES * 64), LDS_BYTES, stream, a); }
#endif
}
```

```cpp
#include <hip/hip_runtime.h>
#include <hip/hip_cooperative_groups.h>
#include <cstdio>
#include <cstdint>
namespace cg = cooperative_groups;
#ifndef MK_PROBE
#define MK_PROBE 0
#endif
#ifndef MK_N_LAUNCHES
#define MK_N_LAUNCHES 1
#endif
namespace pg8 {
#define PG8_LAS __attribute__((address_space(3)))
typedef unsigned short bf16_t;
typedef short bf16x8 __attribute__((ext_vector_type(8)));
typedef float f32x4 __attribute__((ext_vector_type(4)));
typedef unsigned u32x4 __attribute__((ext_vector_type(4)));
constexpr int BM = 256, BK = 64, HALF = 128, HTB = HALF * BK * 2  , STAGE_BYTES = 8 * HTB, NXCD = 8, WGM = 2;

__host__ __device__ __forceinline__ int lds_byte(int r, int c) { const int st = (r >> 4) * 2 + (c >> 5), rr = r & 15, cc = c & 31, ob = rr * 64 + cc * 2; return st * 1024 + (ob ^ (((ob >> 9) & 1) << 5)); }
__host__ __device__ __forceinline__ void stage_rc(int b, int& R, int& C) { const int st = b / 1024, sb = b % 1024, swz = sb ^ (((sb >> 9) & 1) << 5); R = (st >> 1) * 16 + swz / 64; C = (st & 1) * 32 + (swz % 64) / 2; }
__host__ __device__ __forceinline__ int perm32(int rho) { const int n = rho >> 4, i = rho & 15; return 8 * (i >> 2) + 4 * n + (i & 3); }

struct Unit { int pm, pn; };
struct Gemm { const bf16_t* A; const bf16_t* Bt; int M, N, K; int lda; int ksplit; long ajump; };

struct StaticOrder {
    int nM, nN, nwg, G, c;
    __host__ __device__ void init(int M, int N, int G_, int c_) { nM = M / BM; nN = N / BM; nwg = nM * nN; G = G_; c = c_; }
    __host__ __device__ bool next(int i, Unit& u) const {
        const long L = (long)i * G + c; if (L >= nwg) return false;
        int wgid = (int)L; { const int q = nwg / NXCD, r = nwg % NXCD, xcd = wgid % NXCD, off = wgid / NXCD; wgid = (xcd < r ? xcd * (q + 1) : r * (q + 1) + (xcd - r) * q) + off; }
        const int nig = WGM * nN, gid = wgid / nig, fm = gid * WGM, gsz = (nM - fm) < WGM ? (nM - fm) : WGM;
        u.pm = fm + ((wgid % nig) % gsz); u.pn = (wgid % nig) / gsz; return true;
    }
    __device__ __forceinline__ void a_ready(const Unit&) const {}
    __device__ __forceinline__ void done(const Unit&) const {}
};
typedef __bf16 bf16x2v __attribute__((ext_vector_type(2)));
typedef float f32x2 __attribute__((ext_vector_type(2)));
__device__ __forceinline__ unsigned cvt_pk_bf16(float lo, float hi) { const f32x2 v = {lo, hi}; return __builtin_bit_cast(unsigned, __builtin_convertvector(v, bf16x2v)); }
constexpr float kEPS = 1e-6f, kLOG2E = 1.4426950408889634f, kC2 = 0.125f * 1.4426950408889634f;
__device__ __forceinline__ float sigmoid_f(float x) { return __builtin_amdgcn_rcpf(1.0f + __builtin_amdgcn_exp2f(-kLOG2E * x)); }
__device__ __forceinline__ f32x4 sigmoid4(f32x4 x) { const f32x4 t = x * (-kLOG2E); f32x4 e; e[0] = __builtin_amdgcn_exp2f(t[0]); e[1] = __builtin_amdgcn_exp2f(t[1]); e[2] = __builtin_amdgcn_exp2f(t[2]); e[3] = __builtin_amdgcn_exp2f(t[3]);
    e = e + 1.0f; f32x4 r; r[0] = __builtin_amdgcn_rcpf(e[0]); r[1] = __builtin_amdgcn_rcpf(e[1]); r[2] = __builtin_amdgcn_rcpf(e[2]); r[3] = __builtin_amdgcn_rcpf(e[3]); return r; }
__device__ __forceinline__ u32x4 pack8(f32x4 v0, f32x4 v1) { u32x4 w; w.x = cvt_pk_bf16(v0[0], v0[1]); w.y = cvt_pk_bf16(v0[2], v0[3]); w.z = cvt_pk_bf16(v1[0], v1[1]); w.w = cvt_pk_bf16(v1[2], v1[3]); return w; }
struct Epi1 {
    static constexpr bool PERM = true, AFTER_DRAIN = false;
    bf16_t* Z; const float* RS; const float *qg, *kg; PG8_LAS unsigned char* stg;
    static constexpr size_t ZS = (size_t)32 << 20;
    __device__ __forceinline__ void operator()(const f32x4 (&acc)[2][2][4][2], const Unit& u, int wr, int wc, int fr, int fq) const {
        const int pn = u.pn; const int row0 = u.pm * BM + wr * 64 + fr;
        float rsv[2][4];
#pragma unroll
        for (int ai = 0; ai < 2; ++ai)
#pragma unroll
            for (int m = 0; m < 4; ++m) rsv[ai][m] = RS[row0 + ai * HALF + m * 16];
        const int l_ = fr + 16 * fq, rr_ = l_ >> 3, cc_ = l_ & 7;
        PG8_LAS unsigned char* slab = stg + (wr * 4 + wc) * 2304;
        PG8_LAS u32x4* wp = (PG8_LAS u32x4*)(slab + fr * 144 + fq * 16); const PG8_LAS u32x4* rp = (const PG8_LAS u32x4*)(slab + rr_ * 144 + cc_ * 16);
        const size_t rowst = (size_t)(u.pm * BM + wr * 64 + rr_) * 1024;
#define EPI1_STORE128(basep, colw, AI, MM, W0, W1) do { wp[0] = (W0); wp[4] = (W1); asm volatile("s_waitcnt lgkmcnt(0)" ::: "memory"); const u32x4 a_ = rp[0], b_ = rp[72]; asm volatile("s_waitcnt lgkmcnt(0)" ::: "memory"); \
            bf16_t* d_ = (basep) + rowst + (size_t)((AI) * HALF + (MM) * 16) * 1024 + (colw) + 8 * cc_; *(u32x4*)d_ = a_; *(u32x4*)(d_ + 8 * 1024) = b_; } while (0)
        if (pn < 8) {
            const bool isq = pn < 4; const int sec = isq ? pn : pn - 4;
            bf16_t* base = Z + (isq ? 0 : ZS); const float* gp = (isq ? qg : kg) + (sec * 4 + wc) * 64 + 8 * fq; const float sc = isq ? kC2 : 1.0f;
            f32x4 g[2][2];
#pragma unroll
            for (int bj = 0; bj < 2; ++bj)
#pragma unroll
                for (int n = 0; n < 2; ++n) g[bj][n] = *(const f32x4*)(gp + 32 * bj + 4 * n) * sc;
#pragma unroll
            for (int ai = 0; ai < 2; ++ai)
#pragma unroll
                for (int m = 0; m < 4; ++m) {
                    float ss = 0.f;
#pragma unroll
                    for (int bj = 0; bj < 2; ++bj)
#pragma unroll
                        for (int n = 0; n < 2; ++n) { const f32x4 x = acc[ai][bj][m][n]; ss += (x[0] * x[0] + x[1] * x[1]) + (x[2] * x[2] + x[3] * x[3]); }
                    ss += __shfl_xor(ss, 16); ss += __shfl_xor(ss, 32);
                    const float rs = rsv[ai][m];
                    const float rinv = rs * __builtin_amdgcn_rsqf(ss * rs * rs * (1.0f / 64.0f) + kEPS);
                    const u32x4 w0 = pack8(acc[ai][0][m][0] * rinv * g[0][0], acc[ai][0][m][1] * rinv * g[0][1]), w1 = pack8(acc[ai][1][m][0] * rinv * g[1][0], acc[ai][1][m][1] * rinv * g[1][1]);
                    EPI1_STORE128(base, sec * 256 + wc * 64, ai, m, w0, w1);
                }
        } else if (pn < 16 || pn >= 24) {
            const bool act = pn >= 12; const int sec = pn < 12 ? pn - 8 : (pn < 16 ? pn - 12 : pn - 24);
            bf16_t* base = Z + (size_t)(pn < 12 ? 2 : (pn < 16 ? 3 : 5)) * ZS;
#pragma unroll
            for (int ai = 0; ai < 2; ++ai)
#pragma unroll
                for (int m = 0; m < 4; ++m) { const float rs = rsv[ai][m]; u32x4 w[2];
#pragma unroll
                    for (int bj = 0; bj < 2; ++bj) { f32x4 v0 = acc[ai][bj][m][0] * rs, v1 = acc[ai][bj][m][1] * rs;
                        if (act) { v0 = v0 * sigmoid4(v0); v1 = v1 * sigmoid4(v1); }
                        w[bj] = pack8(v0, v1); }
                    EPI1_STORE128(base, sec * 256 + wc * 64, ai, m, w[0], w[1]); }
        } else {
            const int r4 = l_ >> 2, c4 = l_ & 3; const PG8_LAS u32x4* rp4 = (const PG8_LAS u32x4*)(slab + r4 * 144 + c4 * 16);
            bf16_t* ub = Z + 4 * ZS + (size_t)(u.pm * BM + wr * 64 + r4) * 1024 + (pn - 16) * 128 + wc * 32 + 8 * c4;
#pragma unroll
            for (int ai = 0; ai < 2; ++ai)
#pragma unroll
                for (int m = 0; m < 4; ++m) { const float rs = rsv[ai][m]; f32x4 v0 = acc[ai][0][m][0] * rs, v1 = acc[ai][0][m][1] * rs; const f32x4 g0 = acc[ai][1][m][0] * rs, g1 = acc[ai][1][m][1] * rs;
                    v0 = v0 * sigmoid4(g0); v1 = v1 * sigmoid4(g1);
                    wp[0] = pack8(v0, v1); asm volatile("s_waitcnt lgkmcnt(0)" ::: "memory"); const u32x4 a_ = rp4[0]; asm volatile("s_waitcnt lgkmcnt(0)" ::: "memory");
                    *(u32x4*)(ub + (size_t)(ai * HALF + m * 16) * 1024) = a_; }
        }
#undef EPI1_STORE128
    }
};
struct Epi2 {
    static constexpr bool PERM = true, AFTER_DRAIN = false;
    const float* __restrict__ x; float* __restrict__ out; PG8_LAS unsigned char* stg;
    __device__ __forceinline__ void operator()(const f32x4 (&acc)[2][2][4][2], const Unit& u, int wr, int wc, int fr, int fq) const {
        const int l = fr + 16 * fq, rr = l >> 3, cc = l & 7;
        PG8_LAS unsigned char* slab = stg + (wr * 4 + wc) * 2304;
        PG8_LAS f32x4* wp = (PG8_LAS f32x4*)(slab + fr * 144 + fq * 32); const PG8_LAS f32x4* rp = (const PG8_LAS f32x4*)(slab + rr * 144 + cc * 16);
        const size_t g0 = (size_t)(u.pm * BM + wr * 64 + rr) * 1024 + u.pn * BM + wc * 32 + 4 * cc;
        const float* __restrict__ xb = x + g0; float* __restrict__ ob = out + g0;
#pragma unroll
        for (int ai = 0; ai < 2; ++ai) {
            f32x4 pre[4][2][2];
#pragma unroll
            for (int m = 0; m < 4; ++m)
#pragma unroll
                for (int bj = 0; bj < 2; ++bj)
#pragma unroll
                    for (int r = 0; r < 2; ++r) pre[m][bj][r] = *(const f32x4*)(xb + (size_t)(ai * HALF + m * 16 + 8 * r) * 1024 + bj * HALF);
            asm volatile("" ::: "memory");
#pragma unroll
            for (int m = 0; m < 4; ++m)
#pragma unroll
                for (int bj = 0; bj < 2; ++bj) {
                    wp[0] = acc[ai][bj][m][0]; wp[1] = acc[ai][bj][m][1];
                    asm volatile("s_waitcnt lgkmcnt(0)" ::: "memory");
                    const f32x4 v0 = rp[0], v1 = rp[8 * 9];
                    asm volatile("s_waitcnt lgkmcnt(0)" ::: "memory");
                    *(f32x4*)(ob + (size_t)(ai * HALF + m * 16) * 1024 + bj * HALF) = pre[m][bj][0] + v0;
                    *(f32x4*)(ob + (size_t)(ai * HALF + m * 16 + 8) * 1024 + bj * HALF) = pre[m][bj][1] + v1;
                }
            asm volatile("" ::: "memory");
        }
    }
};
template <class Epi, class Sched, bool ALIGN_EPI = false, bool SP2 = false>
__device__ __forceinline__ void gemm_phase(PG8_LAS unsigned char* lds, const Gemm g, const Sched& S, const Epi& E) {
    int tid_ = threadIdx.x; asm volatile("" : "+v"(tid_));
    const int tid = tid_, wid = __builtin_amdgcn_readfirstlane(tid >> 6), lane = tid & 63, wr = wid >> 2, wc = wid & 3, fr = lane & 15, fq = lane >> 4;
    const int K = g.K, nt = K / BK;
    unsigned voffA[2], voffB[2];
#pragma unroll
    for (int i = 0; i < 2; ++i) { int R, C; stage_rc(tid * 16 + i * 8192, R, C); const int Rb = Epi::PERM ? ((R & ~31) + perm32(R & 31)) : R;
        voffA[i] = (unsigned)(R * g.lda + C) * 2u; voffB[i] = (unsigned)(Rb * K + C) * 2u; }
    const size_t kstep = (size_t)(BK * 2);
    const size_t hstepA = (size_t)HALF * g.lda * 2, hstepB = (size_t)HALF * K * 2;
    const size_t tstepA = 2 * hstepA, tstepB = 2 * hstepB;
    const int ksplit = g.ksplit; const long ajump = g.ajump;
#define PG8_KOFF(t) ((size_t)(t) * kstep + ((t) >= ksplit ? ajump : 0l))
    const unsigned ldsw = (unsigned)wid * 1024u;
    const int aoff = lds_byte(wr * 64 + fr, fq * 8), boff = lds_byte(wc * 32 + fr, fq * 8);
#define PG8_SA(b, h) (((b) * 2 + (h)) * HTB)
#define PG8_SB(b, h) ((4 + (b) * 2 + (h)) * HTB)
#define PG8_STAGE(bufoff, gbase, voff) do { _Pragma("unroll") for (int _i = 0; _i < 2; ++_i) \
        __builtin_amdgcn_global_load_lds((const unsigned*)((const char*)(gbase) + (voff)[_i]), (PG8_LAS unsigned*)(lds + (bufoff) + ldsw + _i * 8192), 16, 0, 0); } while (0)
#define PG8_LDA(dst, b, h) do { _Pragma("unroll") for (int m = 0; m < 4; ++m) _Pragma("unroll") for (int k = 0; k < 2; ++k) dst[m][k] = *(const PG8_LAS bf16x8*)(lds + PG8_SA(b, h) + aoff + m * 2048 + k * 1024); } while (0)
#define PG8_LDB(dst, b, h) do { _Pragma("unroll") for (int n = 0; n < 2; ++n) _Pragma("unroll") for (int k = 0; k < 2; ++k) dst[n][k] = *(const PG8_LAS bf16x8*)(lds + PG8_SB(b, h) + boff + n * 2048 + k * 1024); } while (0)
#define PG8_MMA(ai, bj, At, Bt) do { __builtin_amdgcn_s_setprio(1); _Pragma("unroll") for (int m = 0; m < 4; ++m) _Pragma("unroll") for (int n = 0; n < 2; ++n) _Pragma("unroll") for (int k = 0; k < 2; ++k) \
        acc[ai][bj][m][n] = __builtin_amdgcn_mfma_f32_16x16x32_bf16(Bt[n][k], At[m][k], acc[ai][bj][m][n], 0, 0, 0); __builtin_amdgcn_s_setprio(0); } while (0)
#define PG8_WAIT_V(n) asm volatile("s_waitcnt vmcnt(" #n ")" ::: "memory")
#define PG8_WAIT_L(n) asm volatile("s_waitcnt lgkmcnt(" #n ")" ::: "memory")
#define PG8_BAR __builtin_amdgcn_s_barrier()
#define PG8_SCHED __builtin_amdgcn_sched_barrier(0)
    Unit cur, nxt; int ui = 0;
    if (!S.next(0, cur)) return;
    f32x4 acc[2][2][4][2];
#pragma unroll
    for (int a = 0; a < 2; ++a)
#pragma unroll
        for (int b = 0; b < 2; ++b)
#pragma unroll
            for (int m = 0; m < 4; ++m)
#pragma unroll
                for (int n = 0; n < 2; ++n) acc[a][b][m][n] = (f32x4){0.f, 0.f, 0.f, 0.f};
    bf16x8 At[4][2], B0[2][2], B1[2][2];
    const char* cA = (const char*)g.A + (size_t)cur.pm * tstepA; const char* cB = (const char*)g.Bt + (size_t)cur.pn * tstepB;
    S.a_ready(cur);
    if constexpr (SP2) {
        PG8_STAGE(PG8_SB(0, 0), cB, voffB); PG8_STAGE(PG8_SB(0, 1), cB + hstepB, voffB); PG8_STAGE(PG8_SA(0, 0), cA, voffA); PG8_STAGE(PG8_SA(0, 1), cA + hstepA, voffA);
        if (wr == 1) PG8_BAR;
        PG8_WAIT_V(2); PG8_BAR;
        PG8_STAGE(PG8_SB(1, 0), cB + kstep, voffB); PG8_STAGE(PG8_SA(1, 0), cA + kstep, voffA); PG8_STAGE(PG8_SB(1, 1), cB + hstepB + kstep, voffB);
        PG8_WAIT_V(6); PG8_BAR;
    } else {
        PG8_STAGE(PG8_SB(0, 0), cB, voffB); PG8_STAGE(PG8_SA(0, 0), cA, voffA); PG8_STAGE(PG8_SB(0, 1), cB + hstepB, voffB); PG8_STAGE(PG8_SA(0, 1), cA + hstepA, voffA);
        if (wr == 1) PG8_BAR;
        PG8_WAIT_V(4); PG8_BAR;
        PG8_STAGE(PG8_SB(1, 0), cB + kstep, voffB); PG8_STAGE(PG8_SA(1, 0), cA + kstep, voffA); PG8_STAGE(PG8_SB(1, 1), cB + hstepB + kstep, voffB);
        PG8_WAIT_V(6); PG8_BAR;
    }
    for (;;) {
        const bool has_next = S.next(ui + 1, nxt);
        const char* nA = has_next ? (const char*)g.A + (size_t)nxt.pm * tstepA : cA; const char* nB = has_next ? (const char*)g.Bt + (size_t)nxt.pn * tstepB : cB;
        for (int t = 0; t < nt; t += 2) {
            const bool last = (t == nt - 2);
            const char* a1 = cA + PG8_KOFF(t + 1);
            const char* a2 = last ? nA : cA + PG8_KOFF(t + 2); const char* b2 = last ? nB : cB + (size_t)(t + 2) * kstep;
            const char* a3 = a2 + kstep; const char* b3 = b2 + kstep;
            if (last && has_next) S.a_ready(nxt);
            if constexpr (SP2) {
            PG8_LDB(B0, 0, 0); PG8_LDB(B1, 0, 1); PG8_SCHED; PG8_LDA(At, 0, 0); PG8_STAGE(PG8_SA(1, 1), a1 + hstepA, voffA);
            PG8_WAIT_V(8); PG8_WAIT_L(0); PG8_BAR; PG8_MMA(0, 0, At, B0); PG8_MMA(0, 1, At, B1); PG8_BAR; PG8_SCHED;
            PG8_LDA(At, 0, 1); PG8_STAGE(PG8_SB(0, 0), b2, voffB); PG8_STAGE(PG8_SB(0, 1), b2 + hstepB, voffB); PG8_STAGE(PG8_SA(0, 0), a2, voffA);
            PG8_WAIT_V(8); PG8_WAIT_L(0); PG8_BAR; PG8_MMA(1, 0, At, B0); PG8_MMA(1, 1, At, B1); PG8_BAR; PG8_SCHED;
            PG8_LDB(B0, 1, 0); PG8_LDB(B1, 1, 1); PG8_SCHED; PG8_LDA(At, 1, 0); PG8_STAGE(PG8_SA(0, 1), a2 + hstepA, voffA);
            PG8_WAIT_V(8); PG8_WAIT_L(0); PG8_BAR; PG8_MMA(0, 0, At, B0); PG8_MMA(0, 1, At, B1); PG8_BAR; PG8_SCHED;
            PG8_LDA(At, 1, 1); PG8_STAGE(PG8_SB(1, 0), b3, voffB); PG8_STAGE(PG8_SB(1, 1), b3 + hstepB, voffB); PG8_STAGE(PG8_SA(1, 0), a3, voffA);
            PG8_WAIT_V(8); PG8_WAIT_L(0); PG8_BAR; PG8_MMA(1, 0, At, B0); PG8_MMA(1, 1, At, B1); PG8_BAR; PG8_SCHED;
            } else {
            PG8_LDB(B0, 0, 0); PG8_SCHED; PG8_LDA(At, 0, 0); PG8_STAGE(PG8_SA(1, 1), a1 + hstepA, voffA);
            PG8_WAIT_L(8); PG8_BAR; PG8_WAIT_L(0); PG8_MMA(0, 0, At, B0); PG8_BAR; PG8_SCHED;
            PG8_LDB(B1, 0, 1); PG8_STAGE(PG8_SB(0, 0), b2, voffB);
            PG8_BAR; PG8_WAIT_L(0); PG8_MMA(0, 1, At, B1); PG8_BAR;
            PG8_LDA(At, 0, 1); PG8_STAGE(PG8_SA(0, 0), a2, voffA);
            PG8_BAR; PG8_WAIT_L(0); PG8_MMA(1, 0, At, B0); PG8_BAR; PG8_SCHED;
            PG8_STAGE(PG8_SB(0, 1), b2 + hstepB, voffB);
            PG8_WAIT_V(6); PG8_BAR; PG8_MMA(1, 1, At, B1); PG8_BAR;
            PG8_LDB(B0, 1, 0); PG8_SCHED; PG8_LDA(At, 1, 0); PG8_STAGE(PG8_SA(0, 1), a2 + hstepA, voffA);
            PG8_WAIT_L(8); PG8_BAR; PG8_WAIT_L(0); PG8_MMA(0, 0, At, B0); PG8_BAR; PG8_SCHED;
            PG8_LDB(B1, 1, 1); PG8_STAGE(PG8_SB(1, 0), b3, voffB);
            PG8_BAR; PG8_WAIT_L(0); PG8_MMA(0, 1, At, B1); PG8_BAR;
            PG8_LDA(At, 1, 1); PG8_STAGE(PG8_SA(1, 0), a3, voffA);
            PG8_BAR; PG8_WAIT_L(0); PG8_MMA(1, 0, At, B0); PG8_BAR; PG8_SCHED;
            PG8_STAGE(PG8_SB(1, 1), b3 + hstepB, voffB);
            PG8_WAIT_V(6); PG8_BAR; PG8_MMA(1, 1, At, B1); PG8_BAR;
            }
        }
        if constexpr (ALIGN_EPI) { if (wr == 0) PG8_BAR; }
        if constexpr (!Epi::AFTER_DRAIN) { E(acc, cur, wr, wc, fr, fq); S.done(cur); }
        if (!has_next) break;
#pragma unroll
        for (int a = 0; a < 2; ++a)
#pragma unroll
            for (int b = 0; b < 2; ++b)
#pragma unroll
                for (int m = 0; m < 4; ++m)
#pragma unroll
                    for (int n = 0; n < 2; ++n) acc[a][b][m][n] = (f32x4){0.f, 0.f, 0.f, 0.f};
        cur = nxt; cA = nA; cB = nB; ++ui;
        if constexpr (ALIGN_EPI) { if (wr == 1) PG8_BAR; }
    }
    PG8_WAIT_V(0);
    if constexpr (!ALIGN_EPI) { if (wr == 0) PG8_BAR; }
    PG8_BAR;
    if constexpr (Epi::AFTER_DRAIN) { E.fused(acc, cur, wr, wc, fr, fq, lds, wid, lane); S.done(cur); }
#undef PG8_SA
#undef PG8_KOFF
#undef PG8_SB
#undef PG8_STAGE
#undef PG8_LDA
#undef PG8_LDB
#undef PG8_MMA
#undef PG8_WAIT_V
#undef PG8_WAIT_L
#undef PG8_BAR
#undef PG8_SCHED
}
}
#include <hip/hip_bf16.h>
#include <cmath>
namespace attn_body {
using bf16=__hip_bfloat16;
using bf16x8=__attribute__((ext_vector_type(8)))short;
using s16x4=__attribute__((ext_vector_type(4)))short;
using f32x16=__attribute__((ext_vector_type(16)))float;
using u32x4=__attribute__((ext_vector_type(4)))unsigned;
constexpr int BATCH=16,NHEAD=16,SEQ=2048,D=64,DM=NHEAD*D;
constexpr int NW=8,QBLK=32,QB=QBLK*NW,KVBLK=64,NQB=SEQ/QB;
constexpr int ATTN_PITCH=DM, ATTN_UNIT_ROWS=QB;
__device__ __forceinline__ int crow(int r,int hi){return (r&3)+8*(r>>2)+4*hi;}
#define SBAR() __builtin_amdgcn_sched_barrier(0)
__device__ __forceinline__ void cmask(f32x16&p0,f32x16&p1,int jb,int qrel,int hi){
  const float NEG=-INFINITY; int kb=64*jb+4*hi;
  #pragma unroll
  for(int r=0;r<16;++r){int kv=kb+(r&3)+8*(r>>2); if(kv>qrel)p0[r]=NEG; if(kv+32>qrel)p1[r]=NEG;}
}

constexpr int NSLOT=3, SLOTB=8192;
constexpr int LDS_K=0, LDS_V=NSLOT*SLOTB, LDS_WS=2*NSLOT*SLOTB, LDS_OST=LDS_WS+NW*64*4, LDS_BYTES=LDS_OST+NW*4096;
constexpr float C2=0.125f*1.4426950408889634f;
__device__ __forceinline__ void glds16(const void*gsrc,unsigned lds_dst){unsigned keep;
  asm volatile("s_mov_b32 %0, m0\n\ts_mov_b32 m0, %2\n\ts_nop 0\n\tglobal_load_lds_dwordx4 %1, off\n\ts_mov_b32 m0, %0":"=&s"(keep):"v"(gsrc),"s"(lds_dst):"memory");}
__device__ __forceinline__ float max3f(float a,float b,float c){float r;asm("v_max3_f32 %0, %1, %2, %3":"=v"(r):"v"(a),"v"(b),"v"(c));return r;}
__device__ __forceinline__ float max2f(float a,float b){float r;asm("v_max_f32_e32 %0, %1, %2":"=v"(r):"v"(a),"v"(b));return r;}
__device__ __forceinline__ float fadd_s(float a,float b){float r;asm("v_add_f32_e32 %0, %1, %2":"=v"(r):"v"(a),"v"(b));return r;}
__device__ __forceinline__ float fsub_s(float a,float b){float r;asm("v_sub_f32_e32 %0, %1, %2":"=v"(r):"v"(a),"v"(b));return r;}
typedef float f32x2_t __attribute__((ext_vector_type(2))); typedef __bf16 bf16x2_t __attribute__((ext_vector_type(2)));
__device__ __forceinline__ unsigned cvtpk_s(float lo,float hi){f32x2_t v={lo,hi};bf16x2_t b=__builtin_convertvector(v,bf16x2_t);return __builtin_bit_cast(unsigned,b);}
#define WAIT_BAR(N) asm volatile("s_waitcnt vmcnt(" #N ") lgkmcnt(0)\n\ts_barrier":::"memory")

__device__ __forceinline__ void qkt(f32x16&p0,f32x16&p1,const char*Kslot,const bf16x8*qr,int r32,int hi,s16x4 ka0,s16x4 ka1,s16x4 qaug){
  const f32x16 zero=f32x16{};
  const char*kb=Kslot+hi*1024+r32*16;
  #pragma unroll
  for(int d0=0;d0<4;++d0){
    const bf16x8 b0=*reinterpret_cast<const bf16x8*>(kb+d0*2048);
    const bf16x8 b1=*reinterpret_cast<const bf16x8*>(kb+d0*2048+512);
    if(d0==0){p0=__builtin_amdgcn_mfma_f32_32x32x16_bf16(b0,qr[0],zero,0,0,0);p1=__builtin_amdgcn_mfma_f32_32x32x16_bf16(b1,qr[0],zero,0,0,0);}
    else{p0=__builtin_amdgcn_mfma_f32_32x32x16_bf16(b0,qr[d0],p0,0,0,0);p1=__builtin_amdgcn_mfma_f32_32x32x16_bf16(b1,qr[d0],p1,0,0,0);}}
  p0=__builtin_amdgcn_mfma_f32_32x32x8bf16_1k(ka0,qaug,p0,0,0,0);p1=__builtin_amdgcn_mfma_f32_32x32x8bf16_1k(ka1,qaug,p1,0,0,0);
}
typedef __attribute__((address_space(3))) const char* lds_cptr;
typedef short v4i16_t __attribute__((ext_vector_type(4)));
__device__ __forceinline__ void kload8(bf16x8*kf,lds_cptr kp){
  kf[0]=*(const __attribute__((address_space(3))) bf16x8*)(kp);      kf[1]=*(const __attribute__((address_space(3))) bf16x8*)(kp+512);
  kf[2]=*(const __attribute__((address_space(3))) bf16x8*)(kp+2048); kf[3]=*(const __attribute__((address_space(3))) bf16x8*)(kp+2560);
  kf[4]=*(const __attribute__((address_space(3))) bf16x8*)(kp+4096); kf[5]=*(const __attribute__((address_space(3))) bf16x8*)(kp+4608);
  kf[6]=*(const __attribute__((address_space(3))) bf16x8*)(kp+6144); kf[7]=*(const __attribute__((address_space(3))) bf16x8*)(kp+6656);
}
__device__ __forceinline__ void kload2(bf16x8*kf,lds_cptr kp,int j){ kf[2*j]=*(const __attribute__((address_space(3))) bf16x8*)(kp+j*2048); kf[2*j+1]=*(const __attribute__((address_space(3))) bf16x8*)(kp+j*2048+512); }
__device__ __forceinline__ s16x4 vtr(lds_cptr p){ return __builtin_bit_cast(s16x4,__builtin_amdgcn_ds_read_tr16_b64_v4i16((__attribute__((address_space(3))) v4i16_t*)p)); }
__device__ __forceinline__ float rowmax(const f32x16&p0,const f32x16&p1){
  float a=max3f(p0[0],p0[1],p1[0]),b=max3f(p0[2],p0[3],p1[1]);a=max3f(a,p1[2],p1[3]);
  #pragma unroll
  for(int r=4;r<16;r+=4){a=max3f(a,p0[r],p0[r+1]);b=max3f(b,p0[r+2],p0[r+3]);a=max3f(a,p1[r],p1[r+1]);b=max3f(b,p1[r+2],p1[r+3]);}
  const float m=max2f(a,b);
  auto rr=__builtin_amdgcn_permlane32_swap(__float_as_uint(m),__float_as_uint(m),false,false);
  return max2f(__uint_as_float(rr[0]),__uint_as_float(rr[1]));
}
__device__ __forceinline__ void pv(f32x16*o,int vb,bf16x8 pa0,bf16x8 pa1,bf16x8 pa2,bf16x8 pa3){
  #pragma unroll
  for(int d0=0;d0<2;++d0){s16x4 lo[4],hi[4];
    #pragma unroll
    for(int ks=0;ks<4;++ks){
      asm volatile("ds_read_b64_tr_b16 %0,%1 offset:%c2":"=&v"(lo[ks]):"v"(vb),"i"(d0*4096+ks*1024):"memory");
      asm volatile("ds_read_b64_tr_b16 %0,%1 offset:%c2":"=&v"(hi[ks]):"v"(vb),"i"(d0*4096+ks*1024+512):"memory");}
    asm volatile("s_waitcnt lgkmcnt(0)":::"memory");SBAR();
    #define PK(k) (bf16x8){lo[k][0],lo[k][1],lo[k][2],lo[k][3],hi[k][0],hi[k][1],hi[k][2],hi[k][3]}
    o[d0]=__builtin_amdgcn_mfma_f32_32x32x16_bf16(pa0,PK(0),o[d0],0,0,0);
    o[d0]=__builtin_amdgcn_mfma_f32_32x32x16_bf16(pa1,PK(1),o[d0],0,0,0);
    o[d0]=__builtin_amdgcn_mfma_f32_32x32x16_bf16(pa2,PK(2),o[d0],0,0,0);
    o[d0]=__builtin_amdgcn_mfma_f32_32x32x16_bf16(pa3,PK(3),o[d0],0,0,0);
    #undef PK
  }
}

#ifndef ATTN_STORE16
#define ATTN_STORE16(p,v) (*(u32x4*)(p)=(v))
#endif
template<int THRL> __device__ __forceinline__ void attn_unit(int b,int h,int qb,int ts,const bf16*Q,const bf16*__restrict__ K,const bf16*__restrict__ V,bf16*O,const bf16*__restrict__ GF,char*shm,lds_cptr btab){
  int tid_=threadIdx.x; asm volatile("":"+v"(tid_)); const int tid=tid_,lane=tid&63,r32=lane&31,hi=lane>>5; const int wid=__builtin_amdgcn_readfirstlane(tid>>6);
  const long rowbase=(long)b*SEQ; const int q0=qb*QB;
  const bf16*Qw=Q+(rowbase+q0+wid*QBLK)*DM+h*D;
  const bf16*Kh=K+(rowbase+(long)ts*KVBLK)*DM+h*D,*Vh=V+(rowbase+(long)ts*KVBLK)*DM+h*D;
  const unsigned lds0=(unsigned)(uintptr_t)shm;
  float*wsf=(float*)(shm+LDS_WS)+wid*64;
  const bf16*ksrc=Kh+(long)lane*DM+wid*8;
  const bf16*vsrc=Vh+(long)(16*(wid&3)+(lane>>2))*DM+(wid>>2)*32+(lane&3)*8;
  const unsigned kdst=lds0+LDS_K+wid*1024, vdst=lds0+LDS_V+wid*1024;
  #define DMA_K(t,slot) glds16(ksrc+(long)(t)*KVBLK*DM,(unsigned)__builtin_amdgcn_readfirstlane(kdst+(slot)))
  #define DMA_V(t,slot) glds16(vsrc+(long)(t)*KVBLK*DM,(unsigned)__builtin_amdgcn_readfirstlane(vdst+(slot)))
  const int vb0=(int)(lds0+LDS_V)+((lane>>4)&1)*32+(lane&3)*8+(4*hi+((lane&15)>>2))*64;
  const char*Kbase=shm+LDS_K; bf16x8 kf[8];
  const lds_cptr shm3=(lds_cptr)shm; const lds_cptr kp0=shm3+LDS_K+hi*1024+r32*16; const lds_cptr vp0=shm3+LDS_V+((lane>>4)&1)*32+(lane&3)*8+(4*hi+((lane&15)>>2))*64;
  const int NT=(q0+QB)/KVBLK-ts;
  DMA_K(0,0);DMA_V(0,0);DMA_K(1,SLOTB);
  bf16x8 qr[4];
  #pragma unroll
  for(int d0=0;d0<4;++d0)qr[d0]=*reinterpret_cast<const bf16x8*>(&Qw[(long)r32*DM+d0*16+hi*8]);
  typedef unsigned u32x2_t __attribute__((ext_vector_type(2)));
  const lds_cptr bt0=btab+ts*(KVBLK*16)+r32*16+hi*8;
  #define KAUG(t,half) __builtin_bit_cast(s16x4,*(const __attribute__((address_space(3))) u32x2_t*)(bt0+((t)*64+(half)*32)*16))
  u32x2_t qaw=hi?(u32x2_t){0u,0u}:(u32x2_t){0x3F803F80u,0x00003F80u};
  #define QAUG __builtin_bit_cast(s16x4,qaw)
  #define SETQ() do{ const float nm_=-mhat; const unsigned m1_=cvtpk_s(nm_,0.f)&0xffffu; const float r1_=nm_-__uint_as_float(m1_<<16); const unsigned m2_=cvtpk_s(r1_,0.f)&0xffffu; const float r2_=r1_-__uint_as_float(m2_<<16); \
    const unsigned m3_=cvtpk_s(r2_,0.f)&0xffffu; qaw=hi?(u32x2_t){m2_|(m3_<<16),0u}:(u32x2_t){0x3F803F80u,0x3F80u|(m1_<<16)}; }while(0)
  typedef unsigned u32x2_t __attribute__((ext_vector_type(2)));
  float mhat=0.f,l_reg=0.f;f32x16 o[2];o[0]=f32x16{};o[1]=f32x16{};const f32x16 zero16=f32x16{};
  const int qrel=wid*QBLK+r32;
  #define CMASK(P0,P1,t) do{int jb_=(t)-(NT-4); if(jb_>=0)cmask(P0,P1,jb_,qrel,hi);}while(0)
  bool resc=false;
  #define START(P0,P1) do{ const float rm=rowmax(P0,P1); resc=false; \
    { const float dl=rm; mhat=fadd_s(mhat,dl); \
      _Pragma("unroll") for(int r=0;r<16;++r){P0[r]=fsub_s(P0[r],dl);P1[r]=fsub_s(P1[r],dl);} \
      SETQ(); } \
    _Pragma("unroll") for(int r=0;r<16;++r)P0[r]=__builtin_amdgcn_exp2f(P0[r]); }while(0)
  #define RESC() do{ if(resc){ asm volatile("s_waitcnt lgkmcnt(0)":::"memory"); \
      _Pragma("unroll") for(int d_=0;d_<2;++d_) _Pragma("unroll") for(int r=0;r<16;++r)o[d_][r]*=wsf[crow(r,hi)]; } }while(0)
  f32x16 pA0,pA1,pB0,pB1;
  int sl_prev=0,sl_cur=0,sl_next=SLOTB;
  #define ROT() do{sl_prev=sl_cur;sl_cur=sl_next;sl_next=(sl_next==(NSLOT-1)*SLOTB)?0:sl_next+SLOTB;}while(0)
  DMA_K(2,2*SLOTB);
  WAIT_BAR(3);
  qkt(pA0,pA1,Kbase,qr,r32,hi,KAUG(0,0),KAUG(0,1),QAUG);asm volatile("s_nop 15\n\ts_nop 7":"+v"(pA0),"+v"(pA1));CMASK(pA0,pA1,0);
  START(pA0,pA1);
  _Pragma("unroll") for(int r=0;r<16;++r)pA1[r]=__builtin_amdgcn_exp2f(pA1[r]);
  WAIT_BAR(0);
  DMA_K(3,0);DMA_V(1,SLOTB);
  ROT();
  kload8(kf,kp0+sl_cur);
  WAIT_BAR(2);
  s16x4 vlo[8],vhi[8]; u32x4 pw0,pw1,pw2,pw3;
  #define PKW(P,B) cvtpk_s(P[B],P[B+1])
  #define PAF(k) __builtin_bit_cast(bf16x8,pw##k)
  #define VFR(i) (bf16x8){vlo[i][0],vlo[i][1],vlo[i][2],vlo[i][3],vhi[i][0],vhi[i][1],vhi[i][2],vhi[i][3]}
  #define PIN(x) asm volatile("":"+v"(x))
  #define MX3(a,b,c) __builtin_fmaxf(__builtin_fmaxf((a),(b)),(c))
  #define GAPA(MF,A0,A1,A2,A3,W0,W1,PW) do{ MF; sacc+=A0; sacc+=A1; sacc+=A2; sacc+=A3; PIN(sacc); W0; W1; PIN(PW); SBAR(); }while(0)
  #define EX(v) __builtin_amdgcn_exp2f(v)
  #define GAPB(MF,X,B) do{ MF; X[B]=EX(X[B]); X[B+1]=EX(X[B+1]); X[B+2]=EX(X[B+2]); X[B+3]=EX(X[B+3]); PIN(X); SBAR(); }while(0)
  #define VRD(i) do{ vlo[i]=vtr(vp_+(((i)>>2)*4096+((i)&3)*1024)); vhi[i]=vtr(vp_+(((i)>>2)*4096+((i)&3)*1024+512)); }while(0)
  #define KRD(G,j) do{ if(G){ kload2(kf,kp0+sl_next,j); SBAR(); } }while(0)
  #define STEP(C0,C1,P0,P1,t,GK,GV,GL) do{ SBAR(); \
    const lds_cptr vp_=vp0+sl_prev; const s16x4 ka0_=KAUG(t,0),ka1_=KAUG(t,1); \
    VRD(0); SBAR(); float sacc=(P0[0]+P0[1]); \
    GAPA(C0=__builtin_amdgcn_mfma_f32_32x32x16_bf16(kf[0],qr[0],zero16,0,0,0), P0[2],P0[3],P0[4],P0[5],     pw0[0]=PKW(P0,0), pw0[1]=PKW(P0,2), pw0); \
    VRD(4); SBAR(); GAPA(C1=__builtin_amdgcn_mfma_f32_32x32x16_bf16(kf[1],qr[0],zero16,0,0,0), P0[6],P0[7],P0[8],P0[9],     pw0[2]=PKW(P0,4), pw0[3]=PKW(P0,6), pw0); \
    VRD(1); SBAR(); GAPA(C0=__builtin_amdgcn_mfma_f32_32x32x16_bf16(kf[2],qr[1],C0,0,0,0),   P0[10],P0[11],P0[12],P0[13], pw1[0]=PKW(P0,8), pw1[1]=PKW(P0,10), pw1); \
    VRD(5); SBAR(); GAPA(C1=__builtin_amdgcn_mfma_f32_32x32x16_bf16(kf[3],qr[1],C1,0,0,0),   P0[14],P0[15],P1[0],P1[1],   pw1[2]=PKW(P0,12),pw1[3]=PKW(P0,14), pw1); \
    VRD(2); SBAR(); GAPA(C0=__builtin_amdgcn_mfma_f32_32x32x16_bf16(kf[4],qr[2],C0,0,0,0),   P1[2],P1[3],P1[4],P1[5],     pw2[0]=PKW(P1,0), pw2[1]=PKW(P1,2), pw2); \
    VRD(6); SBAR(); GAPA(C1=__builtin_amdgcn_mfma_f32_32x32x16_bf16(kf[5],qr[2],C1,0,0,0),   P1[6],P1[7],P1[8],P1[9],     pw2[2]=PKW(P1,4), pw2[3]=PKW(P1,6), pw2); \
    VRD(3); SBAR(); GAPA(C0=__builtin_amdgcn_mfma_f32_32x32x16_bf16(kf[6],qr[3],C0,0,0,0),   P1[10],P1[11],P1[12],P1[13], pw3[0]=PKW(P1,8), pw3[1]=PKW(P1,10), pw3); \
    VRD(7); SBAR(); GAPA(C1=__builtin_amdgcn_mfma_f32_32x32x16_bf16(kf[7],qr[3],C1,0,0,0),   P1[14],P1[15],0.f,0.f,       pw3[2]=PKW(P1,12),pw3[3]=PKW(P1,14), pw3); \
    C0=__builtin_amdgcn_mfma_f32_32x32x8bf16_1k(ka0_,QAUG,C0,0,0,0); C1=__builtin_amdgcn_mfma_f32_32x32x8bf16_1k(ka1_,QAUG,C1,0,0,0); \
    l_reg+=sacc; \
    if(GK){DMA_K((t)+3,sl_cur);} if(GV){DMA_V((t)+1,sl_next);} \
    CMASK(C0,C1,t); \
    { float a=MX3(C0[0],C0[1],C1[0]),b=MX3(C0[2],C0[3],C1[1]); a=MX3(a,C1[2],C1[3]); \
      _Pragma("unroll") for(int r=4;r<16;r+=4){a=MX3(a,C0[r],C0[r+1]);b=MX3(b,C0[r+2],C0[r+3]);a=MX3(a,C1[r],C1[r+1]);b=MX3(b,C1[r+2],C1[r+3]);} \
      float rm=__builtin_fmaxf(a,b); { auto rr=__builtin_amdgcn_permlane32_swap(__float_as_uint(rm),__float_as_uint(rm),false,false); rm=__builtin_fmaxf(__uint_as_float(rr[0]),__uint_as_float(rr[1])); } \
      resc=false; \
      if(__builtin_expect(__any(rm>(float)THRL),0)){ const float dl=__builtin_fmaxf(rm,0.f); mhat+=dl; \
        _Pragma("unroll") for(int r=0;r<16;++r){C0[r]-=dl;C1[r]-=dl;} \
        SETQ(); \
        const float f=__builtin_amdgcn_exp2f(-dl); l_reg*=f; if(hi==0)wsf[r32]=f; resc=true; } } \
    SBAR(); \
    GAPB(o[0]=__builtin_amdgcn_mfma_f32_32x32x16_bf16(PAF(0),VFR(0),o[0],0,0,0), C0,0); \
    GAPB(o[1]=__builtin_amdgcn_mfma_f32_32x32x16_bf16(PAF(0),VFR(4),o[1],0,0,0), C0,4); \
    KRD(GL,0); GAPB(o[0]=__builtin_amdgcn_mfma_f32_32x32x16_bf16(PAF(1),VFR(1),o[0],0,0,0), C0,8); \
    KRD(GL,1); GAPB(o[1]=__builtin_amdgcn_mfma_f32_32x32x16_bf16(PAF(1),VFR(5),o[1],0,0,0), C0,12); \
    KRD(GL,2); GAPB(o[0]=__builtin_amdgcn_mfma_f32_32x32x16_bf16(PAF(2),VFR(2),o[0],0,0,0), C1,0); \
    KRD(GL,3); GAPB(o[1]=__builtin_amdgcn_mfma_f32_32x32x16_bf16(PAF(2),VFR(6),o[1],0,0,0), C1,4); \
    GAPB(o[0]=__builtin_amdgcn_mfma_f32_32x32x16_bf16(PAF(3),VFR(3),o[0],0,0,0), C1,8); \
    GAPB(o[1]=__builtin_amdgcn_mfma_f32_32x32x16_bf16(PAF(3),VFR(7),o[1],0,0,0), C1,12); \
    }while(0)
  int t=1;
  #undef CMASK
  #define CMASK(P0,P1,t) do{}while(0)
  for(;t+5<NT;t+=2){
    STEP(pB0,pB1,pA0,pA1,t,true,true,true);     WAIT_BAR(2); RESC(); ROT();
    STEP(pA0,pA1,pB0,pB1,t+1,true,true,true);   WAIT_BAR(2); RESC(); ROT();
  }
  #undef CMASK
  #define CMASK(P0,P1,t) do{int jb_=(t)-(NT-4); if(jb_>=0)cmask(P0,P1,jb_,qrel,hi);}while(0)
  #define ENDW(tt) do{ if((tt)+3<NT){WAIT_BAR(2);} else if((tt)+2<NT){WAIT_BAR(1);} else {WAIT_BAR(0);} }while(0)
  for(;t+1<NT;t+=2){
    STEP(pB0,pB1,pA0,pA1,t,(t+3<NT),(t+1<NT),(t+1<NT));       ENDW(t);   RESC(); ROT();
    STEP(pA0,pA1,pB0,pB1,t+1,(t+4<NT),(t+2<NT),(t+2<NT));     ENDW(t+1); RESC(); ROT();
  }
  #define DRAIN(P0,P1,slot) do{ float sacc=P0[0]+P0[1]; _Pragma("unroll") for(int r=2;r<16;++r)sacc+=P0[r]; _Pragma("unroll") for(int r=0;r<16;++r)sacc+=P1[r]; l_reg+=sacc; \
    pw0=(u32x4){PKW(P0,0),PKW(P0,2),PKW(P0,4),PKW(P0,6)};pw1=(u32x4){PKW(P0,8),PKW(P0,10),PKW(P0,12),PKW(P0,14)};pw2=(u32x4){PKW(P1,0),PKW(P1,2),PKW(P1,4),PKW(P1,6)};pw3=(u32x4){PKW(P1,8),PKW(P1,10),PKW(P1,12),PKW(P1,14)}; \
    SBAR(); pv(o,vb0+(slot),PAF(0),PAF(1),PAF(2),PAF(3)); }while(0)
  if(wid>=6){ STEP(pB0,pB1,pA0,pA1,NT-1,false,false,false); RESC(); DRAIN(pB0,pB1,sl_cur); }
  else if(wid>=4){ DRAIN(pA0,pA1,sl_prev); }
  #undef DRAIN
  #undef PKW
  #undef PAF
  #undef VFR
  #undef PIN
  #undef MX3
  #undef GAPA
  #undef GAPB
  #undef EX
  #undef VRD
  #undef KRD
  #undef STEP
  #undef ENDW
  {auto rr=__builtin_amdgcn_permlane32_swap(__float_as_uint(l_reg),__float_as_uint(l_reg),false,false);l_reg=__uint_as_float(rr[0])+__uint_as_float(rr[1]);}
  if(hi==0)wsf[32+r32]=l_reg;asm volatile("s_waitcnt lgkmcnt(0)":::"memory");
  float rli[16];
  #pragma unroll
  for(int r=0;r<16;++r)rli[r]=__builtin_amdgcn_rcpf(wsf[32+crow(r,hi)]);
  bf16*Ow=O+(rowbase+q0+wid*QBLK)*DM+h*D; const bf16*Gw=GF+(rowbase+q0+wid*QBLK)*DM+h*D;
  u32x4 gv[4];
  #pragma unroll
  for(int i=0;i<4;++i){const int row=i*8+(lane>>3),ch=lane&7; gv[i]=*(const u32x4*)(Gw+(long)row*DM+ch*8);}
  { bf16*stg=(bf16*)(shm+LDS_OST)+wid*2048;
    #pragma unroll
    for(int r=0;r<16;++r){const int orow=crow(r,hi);
      #pragma unroll
      for(int d0=0;d0<2;++d0)stg[orow*64+d0*32+r32]=__float2bfloat16(o[d0][r]*rli[r]);}
    asm volatile("s_waitcnt lgkmcnt(0)":::"memory");
    #pragma unroll
    for(int i=0;i<4;++i){const int row=i*8+(lane>>3),ch=lane&7; u32x4 v=*(const u32x4*)(stg+row*64+ch*8);
      #pragma unroll
      for(int j=0;j<4;++j){const unsigned a=v[j],g=gv[i][j]; v[j]=cvtpk_s(__uint_as_float(a<<16)*__uint_as_float(g<<16),__uint_as_float(a&0xffff0000u)*__uint_as_float(g&0xffff0000u));}
      ATTN_STORE16(Ow+(long)row*DM+ch*8,v);} }
  asm volatile("s_waitcnt lgkmcnt(0)\n\ts_barrier":::"memory");
  #undef DMA_K
  #undef KAUG
  #undef QAUG
  #undef SETQ
  #undef DMA_V
  #undef CMASK
  #undef START
  #undef RESC
  #undef ROT
}
constexpr int ATTN_LDS_BYTES=LDS_BYTES;
struct AttnTensors { const bf16* Q; const bf16* K; const bf16* V; bf16* O; const bf16* GF; };
#undef SBAR
#undef WAIT_BAR
}
constexpr int NWAVES = 8;
constexpr int BATCH = 16, SEQ = 2048, DMODEL = 1024, NH = 16, HD = 64, CK = 31;
constexpr int M = BATCH * SEQ;
constexpr int IN_COLS = 7184;
constexpr int O_Q = 0, O_K = 1024, O_V = 2048, O_F = 3072, O_GF = 3088, O_GLU = 4112, O_GC = 6160;
constexpr int N1 = 28 * 256;
constexpr int K2 = 2048;
constexpr size_t MiB = 1u << 20;
constexpr int CW_CONV = 3520;
constexpr size_t WS_CTL = 0, CTL_ZERO_BYTES = 16384;
constexpr size_t WS_BT1 = 2 * MiB;
constexpr size_t WS_BT2 = 18 * MiB;
constexpr size_t WS_RS = 26 * MiB;
constexpr size_t WS_LF = 24 * MiB;
constexpr size_t WS_XN = 32 * MiB;
constexpr size_t WS_Q = 96 * MiB, WS_K = 160 * MiB, WS_V = 224 * MiB, WS_GF = 288 * MiB, WS_U = 352 * MiB, WS_GC = 416 * MiB, WS_END = 480 * MiB;
constexpr int RING_BYTES = 131072;
constexpr int LDS_BYTES = 151552;
constexpr int BT_OFF = 98304, BT_BYTES = 32768, WT_OFF = BT_OFF + BT_BYTES;
constexpr int MISC_OFF = WT_OFF + 128;
constexpr int ESTG_OFF = WT_OFF + 512, ESTG_BYTES = 8 * 2304;
static_assert(ESTG_OFF + ESTG_BYTES <= LDS_BYTES, "LDS map");
static_assert(attn_body::ATTN_LDS_BYTES <= BT_OFF && MISC_OFF + 64 <= LDS_BYTES, "LDS map");

#define GAS __attribute__((address_space(1)))
#define LAS __attribute__((address_space(3)))
typedef unsigned short bf16;
typedef unsigned v4u __attribute__((ext_vector_type(4)));
typedef unsigned v2u __attribute__((ext_vector_type(2)));
typedef float f32x4 __attribute__((ext_vector_type(4)));
typedef float f32x2 __attribute__((ext_vector_type(2)));
__device__ __forceinline__ unsigned f2bf(float f) { unsigned u = __builtin_bit_cast(unsigned, f); return (u + 0x7fffu + ((u >> 16) & 1u)) >> 16; }
__device__ __forceinline__ unsigned pk2(float lo, float hi) { return f2bf(lo) | (f2bf(hi) << 16); }
__device__ __forceinline__ float bf_lo(unsigned w) { return __uint_as_float(w << 16); }
__device__ __forceinline__ float bf_hi(unsigned w) { return __uint_as_float(w & 0xffff0000u); }
__device__ __forceinline__ float wave_sum(float v) {
#pragma unroll
    for (int o = 1; o < 64; o <<= 1) v += __shfl_xor(v, o);
    return v;
}
struct Args { const float* in[11]; float* out; unsigned char* ws; int ph_lo, ph_hi; };
typedef const __attribute__((address_space(4))) Args* KArgs;

#define RLX_AGENT __ATOMIC_RELAXED, __HIP_MEMORY_SCOPE_AGENT
#define LDS_WAIT() asm volatile("s_waitcnt lgkmcnt(0)" ::: "memory")
#define VM_WAIT() asm volatile("s_waitcnt vmcnt(0)" ::: "memory")
#define XB_TMO      128
#define XB_XCNT(j)  (256  + 64 * (j))
#define XB_XSUB(j)  (1280 + 64 * (j))
#define XB_XGEN(j)  (2304 + 64 * (j))
#define XB_TOP      3328
#define XB_TOPGEN   3392
#define XCD_BAR_WORDS 3456
#define XB_SPIN_CAP (1u << 18)

__device__ __forceinline__ unsigned xb_ld(unsigned* p)              { return __hip_atomic_load(p, __ATOMIC_RELAXED, __HIP_MEMORY_SCOPE_AGENT); }
__device__ __forceinline__ unsigned xb_add(unsigned* p, unsigned v) { return __hip_atomic_fetch_add(p, v, __ATOMIC_RELAXED, __HIP_MEMORY_SCOPE_AGENT); }
__device__ __forceinline__ unsigned xb_xcc_id() { return (unsigned)__builtin_amdgcn_s_getreg((3 << 11) | 20) & 0xFu; }
#define XB_SPIN(cond, bar) do { unsigned _sp = 0; while (cond) { __builtin_amdgcn_s_sleep(1); \
    if ((++_sp & 255u) == 0u) { if (xb_ld(&(bar)[XB_TMO])) break; if (_sp > XB_SPIN_CAP) { atomicAdd(&(bar)[XB_TMO], 1u); break; } } } } while (0)

struct XcdBarrier {
    unsigned* bar; unsigned x;
    volatile LAS unsigned* st;
};

__device__ __forceinline__ XcdBarrier xcd_barrier_post(unsigned* bar, volatile LAS unsigned* st) {
    XcdBarrier b; b.bar = bar; b.x = xb_xcc_id(); b.st = st;
    if (threadIdx.x == 0) (void)xb_add(&bar[XB_XCNT(b.x)], 1u);
    return b;
}
__device__ __forceinline__ void xcd_barrier_complete(unsigned* bar, unsigned x, unsigned& nloc, unsigned& nx) {
    const unsigned G = gridDim.x * gridDim.y * gridDim.z;
    unsigned sum, cnt, mine, sp = 0u;
    for (;;) {
        sum = 0u; cnt = 0u; mine = 0u;
#pragma unroll
        for (unsigned j = 0; j < 16; ++j) { const unsigned c = xb_ld(&bar[XB_XCNT(j)]); sum += c; cnt += (c > 0u) ? 1u : 0u; mine = (j == x) ? c : mine; }
        if (sum == G) break;
        __builtin_amdgcn_s_sleep(1);
        if ((++sp & 255u) == 0u) { if (xb_ld(&bar[XB_TMO])) break; if (sp > XB_SPIN_CAP) { atomicAdd(&bar[XB_TMO], 1u); break; } }
    }
    nloc = mine > 0u ? mine : 1u; nx = cnt > 0u ? cnt : 1u;
}

__device__ __forceinline__ void xcd_barrier(const XcdBarrier& b) {
    asm volatile("s_waitcnt vmcnt(0)" ::: "memory");
    __syncthreads();
    if (threadIdx.x == 0) {
        unsigned* bar = b.bar;
        __builtin_amdgcn_s_waitcnt(0);
        unsigned nloc = b.st[0], nx = b.st[1];
        if (nloc == 0u) { xcd_barrier_complete(bar, b.x, nloc, nx); b.st[0] = nloc; b.st[1] = nx; }
        const unsigned old = xb_add(&bar[XB_XSUB(b.x)], 1u);
        const unsigned gen = old / nloc;
        if (old + 1u == (gen + 1u) * nloc) {
            __builtin_amdgcn_fence(__ATOMIC_RELEASE, "agent");
            asm volatile("s_waitcnt vmcnt(0)" ::: "memory");
            const unsigned og = xb_add(&bar[XB_TOP], 1u);
            const unsigned tg = og / nx;
            if (og + 1u == (tg + 1u) * nx) xb_add(&bar[XB_TOPGEN], 1u);
            else XB_SPIN(xb_ld(&bar[XB_TOPGEN]) == tg, bar);
            __builtin_amdgcn_fence(__ATOMIC_ACQUIRE, "agent");
            xb_add(&bar[XB_XGEN(b.x)], 1u);
            asm volatile("s_waitcnt vmcnt(0)" ::: "memory");
        } else {
            XB_SPIN(xb_ld(&bar[XB_XGEN(b.x)]) == gen, bar);
            __builtin_amdgcn_fence(__ATOMIC_ACQUIRE, "agent");
            asm volatile("s_waitcnt vmcnt(0)" ::: "memory");
        }
    }
    __syncthreads();
}

__device__ __forceinline__ void p0_transpose_item(const float* __restrict__ W, int ldw, int src_col0, const float* __restrict__ gk, bool use_g, bf16* __restrict__ WT, int K, int dst_row0, int kb, LAS float* scr, int lane) {
    const int k0 = 64 * kb, c = lane & 31, kh = lane >> 5;
    const float* __restrict__ wp = W + (size_t)(k0 + kh) * ldw + src_col0 + c; const float* __restrict__ gp = gk + ((k0 + kh) & (DMODEL - 1));
    float v[32], gg[32];
#pragma unroll
    for (int i = 0; i < 32; ++i) { v[i] = wp[(size_t)(2 * i) * ldw]; gg[i] = gp[2 * i]; }
    asm volatile("" ::: "memory");
#pragma unroll
    for (int i = 0; i < 32; ++i) scr[(2 * i + kh) * 33 + c] = v[i] * (use_g ? gg[i] : 1.0f);
    asm volatile("s_waitcnt lgkmcnt(0)" ::: "memory");
    const int c8 = lane & 7;
#pragma unroll
    for (int j = 0; j < 4; ++j) { const int n = (lane >> 3) + 8 * j; const LAS float* s = scr + (8 * c8) * 33 + n;
        v4u o; o.x = pk2(s[0 * 33], s[1 * 33]); o.y = pk2(s[2 * 33], s[3 * 33]); o.z = pk2(s[4 * 33], s[5 * 33]); o.w = pk2(s[6 * 33], s[7 * 33]);
        *(v4u*)(WT + (size_t)(dst_row0 + n) * K + k0 + 8 * c8) = o; }
    asm volatile("s_waitcnt lgkmcnt(0)" ::: "memory");
}
__device__ __forceinline__ int bt1_src(int rg) {
    const int pn = rg >> 3, tcg = rg & 7, bj = tcg >> 2, wc = tcg & 3;
    if (pn < 4)  return O_Q + 256 * pn + 64 * wc + 32 * bj;
    if (pn < 8)  return O_K + 256 * (pn - 4) + 64 * wc + 32 * bj;
    if (pn < 12) return O_V + 256 * (pn - 8) + 64 * wc + 32 * bj;
    if (pn < 16) return O_GF + 256 * (pn - 12) + 64 * wc + 32 * bj;
    if (pn < 24) return O_GLU + 1024 * bj + 128 * (pn - 16) + 32 * wc;
    return O_GC + 256 * (pn - 24) + 64 * wc + 32 * bj;
}
__device__ __forceinline__ void p0_prologue(KArgs Ap, LAS unsigned char* lds, int vcu, int G, int tid, int wave, int lane) {
    LAS float* scr = (LAS float*)(lds + wave * 16384);
    const int gw = vcu * NWAVES + wave, NGW = G * NWAVES;
    const float* w_in = Ap->in[2]; const float* w_out = Ap->in[10]; const float* ng = Ap->in[1]; unsigned char* ws = Ap->ws;
    bf16* BT1 = (bf16*)(ws + WS_BT1); bf16* BT2 = (bf16*)(ws + WS_BT2);
    constexpr int I1 = (N1 / 32) * 16, I2 = (DMODEL / 32) * (K2 / 64);
    for (int it = gw; it < I1 + I2; it += NGW) {
        if (it < I1) { const int rg = it >> 4, kb = it & 15; p0_transpose_item(w_in, IN_COLS, bt1_src(rg), ng, true, BT1, DMODEL, rg * 32, kb, scr, lane); }
        else { const int r = it - I1, n32 = r >> 5, kb = r & 31; p0_transpose_item(w_out, DMODEL, n32 * 32, ng, false, BT2, K2, n32 * 32, kb, scr, lane); }
    }
    __syncthreads();
    LAS v4u* wf = (LAS v4u*)lds;
    for (int e = tid; e < 32 * 64; e += NWAVES * 64) { const int kk = e >> 6, l = e & 63, kb = 32 * kk + 8 * (l >> 4), hd = l & 15; float v[8];
#pragma unroll
        for (int i = 0; i < 8; ++i) v[i] = w_in[(size_t)(kb + i) * IN_COLS + O_F + hd] * ng[kb + i];
        wf[e] = (v4u){pk2(v[0], v[1]), pk2(v[2], v[3]), pk2(v[4], v[5]), pk2(v[6], v[7])}; }
    __syncthreads();
    const float* x = Ap->in[0]; const float* bfg = Ap->in[3]; bf16* XN = (bf16*)(ws + WS_XN); float* RS = (float*)(ws + WS_RS); float* LF = (float*)(ws + WS_LF);
    const int fr = lane & 15, fq = lane >> 4;
    for (int grp = gw; grp < M / 16; grp += NGW) {
        const int r0 = grp * 16;
        const f32x4* __restrict__ xp = (const f32x4*)(x + (size_t)(r0 + fr) * DMODEL + 8 * fq); v4u* __restrict__ op = (v4u*)(XN + (size_t)(r0 + fr) * DMODEL + 8 * fq);
        pg8::f32x4 acc = {0.f, 0.f, 0.f, 0.f}; float ss = 0.f;
        f32x4 cur[8][2], nxt[8][2];
#pragma unroll
        for (int j = 0; j < 8; ++j) { cur[j][0] = __builtin_nontemporal_load(xp + 8 * j); cur[j][1] = __builtin_nontemporal_load(xp + 8 * j + 1); }
#pragma unroll
        for (int kb8 = 0; kb8 < 32; kb8 += 8) {
            if (kb8 + 8 < 32) {
#pragma unroll
                for (int j = 0; j < 8; ++j) { nxt[j][0] = __builtin_nontemporal_load(xp + 8 * (kb8 + 8 + j)); nxt[j][1] = __builtin_nontemporal_load(xp + 8 * (kb8 + 8 + j) + 1); }
            }
            asm volatile("" ::: "memory");
#pragma unroll
            for (int j = 0; j < 8; ++j) { const int kk = kb8 + j; const f32x4 a0 = cur[j][0], a1 = cur[j][1];
                ss += (a0.x * a0.x + a0.y * a0.y) + (a0.z * a0.z + a0.w * a0.w) + (a1.x * a1.x + a1.y * a1.y) + (a1.z * a1.z + a1.w * a1.w);
                const v4u av = {attn_body::cvtpk_s(a0.x, a0.y), attn_body::cvtpk_s(a0.z, a0.w), attn_body::cvtpk_s(a1.x, a1.y), attn_body::cvtpk_s(a1.z, a1.w)};
                op[4 * kk] = av;
                acc = __builtin_amdgcn_mfma_f32_16x16x32_bf16(__builtin_bit_cast(pg8::bf16x8, av), __builtin_bit_cast(pg8::bf16x8, wf[kk * 64 + lane]), acc, 0, 0, 0); }
            asm volatile("" ::: "memory");
#pragma unroll
            for (int j = 0; j < 8; ++j) { cur[j][0] = nxt[j][0]; cur[j][1] = nxt[j][1]; }
        }
        ss += __shfl_xor(ss, 16); ss += __shfl_xor(ss, 32);
        const float rs = 1.0f / sqrtf(ss * (1.f / DMODEL) + pg8::kEPS);
        if (fq == 0) RS[r0 + fr] = rs;
        const float bb = bfg[fr];
#pragma unroll
        for (int e = 0; e < 4; ++e) { const int r = 4 * fq + e; const float z = __shfl(rs, r) * acc[e] + bb;
            LF[(size_t)(r0 + r) * 16 + fr] = fminf(z, 0.f) - log1pf(expf(-fabsf(z))); }
    }
}

__device__ __forceinline__ f32x2 unpk(unsigned w) { return (f32x2){bf_lo(w), bf_hi(w)}; }
__device__ __forceinline__ void conv_phase(KArgs Ap, LAS unsigned char* lds, int vcu, int G, int tid, int wave, int lane, size_t out_off) {
    (void)vcu; (void)G;
    LAS float* red = (LAS float*)lds;
    LAS f32x2* fin = (LAS f32x2*)(lds + 1024);
    const int c0 = 2 * tid;
    const float* cw = Ap->in[6]; unsigned char* ws = Ap->ws;
    f32x2 w[CK];
#pragma unroll
    for (int j = 0; j < CK; ++j) w[j] = *(const f32x2*)(cw + j * 1024 + c0);
    const f32x2 cb = *(const f32x2*)(Ap->in[7] + c0), lg = *(const f32x2*)(Ap->in[8] + c0), lb = *(const f32x2*)(Ap->in[9] + c0);
    const bf16* U = (const bf16*)(ws + WS_U); bf16* GC = (bf16*)(ws + WS_GC);
    unsigned* ctr = (unsigned*)(ws + WS_CTL) + CW_CONV; volatile LAS int* ubox = (volatile LAS int*)(lds + 2048);
    for (;;) {
        if (tid == 0) ubox[0] = (int)__hip_atomic_fetch_add(ctr, 1u, __ATOMIC_RELAXED, __HIP_MEMORY_SCOPE_AGENT);
        __syncthreads();
        const int unit = ubox[0];
        __syncthreads();
        if (unit >= M / 64) break;
        const int row0 = unit * 64, t0 = row0 & (SEQ - 1);
        const bf16* Up = U + (size_t)row0 * 1024 + c0; bf16* Gp = GC + (size_t)row0 * 1024 + c0; bf16* Op = (bf16*)(ws + out_off) + (size_t)row0 * 1024 + c0;
        f32x2 win[38];
#pragma unroll
        for (int i = 0; i < 30; ++i) { const unsigned raw = (t0 - 30 + i >= 0) ? *(const unsigned*)(Up + (long)(i - 30) * 1024) : 0u; win[i] = unpk(raw); }
        unsigned nx[8], nx2[8], gcn[8];
#pragma unroll
        for (int i = 0; i < 8; ++i) nx[i] = *(const unsigned*)(Up + (long)i * 1024);
#pragma unroll
        for (int i = 0; i < 8; ++i) nx2[i] = *(const unsigned*)(Up + (long)(8 + i) * 1024);
#pragma unroll
        for (int i = 0; i < 8; ++i) gcn[i] = *(const unsigned*)(Gp + (long)i * 1024);
#pragma unroll 1
        for (int ch = 0; ch < 8; ++ch) {
            unsigned gcr[8];
#pragma unroll
            for (int i = 0; i < 8; ++i) { win[30 + i] = unpk(nx[i]); nx[i] = nx2[i]; gcr[i] = gcn[i]; }
            { const int c2 = (ch + 2 < 8) ? ch + 2 : 7, c1 = (ch + 1 < 8) ? ch + 1 : 7;
#pragma unroll
              for (int i = 0; i < 8; ++i) nx2[i] = *(const unsigned*)(Up + (long)(c2 * 8 + i) * 1024);
#pragma unroll
              for (int i = 0; i < 8; ++i) gcn[i] = *(const unsigned*)(Gp + (long)(c1 * 8 + i) * 1024); }
            f32x2 y[8];
#pragma unroll
            for (int i = 0; i < 8; ++i) { f32x2 a = cb;
#pragma unroll
                for (int j = 0; j < CK; ++j) a += w[j] * win[i + j];
                y[i] = a; }
            float st[16];
#pragma unroll
            for (int i = 0; i < 8; ++i) { st[2 * i] = y[i].x + y[i].y; st[2 * i + 1] = y[i].x * y[i].x + y[i].y * y[i].y; }
            {
#pragma unroll
              for (int k = 0; k < 8; ++k) { const auto r = __builtin_amdgcn_permlane32_swap(__float_as_uint(st[k]), __float_as_uint(st[k + 8]), false, false); st[k] = __uint_as_float(r[0]) + __uint_as_float(r[1]); }
#pragma unroll
              for (int k = 0; k < 4; ++k) { const auto r = __builtin_amdgcn_permlane16_swap(__float_as_uint(st[k]), __float_as_uint(st[k + 4]), false, false); st[k] = __uint_as_float(r[0]) + __uint_as_float(r[1]); }
              const bool h3 = (lane & 8) != 0;
#pragma unroll
              for (int k = 0; k < 2; ++k) { const float send = h3 ? st[k] : st[k + 2], keep = h3 ? st[k + 2] : st[k]; st[k] = keep + __shfl_xor(send, 8); }
              const bool h2 = (lane & 4) != 0;
              { const float send = h2 ? st[0] : st[1], keep = h2 ? st[1] : st[0]; st[0] = keep + __shfl_xor(send, 4); }
              st[0] += __shfl_xor(st[0], 2); st[0] += __shfl_xor(st[0], 1); }
            const int pb = ch & 1;
            if ((lane & 3) == 0) red[(pb * 8 + wave) * 16 + ((lane >> 2) & 15)] = st[0];
            __syncthreads();
            if (tid < 8) { float s1 = 0.f, s2 = 0.f;
#pragma unroll
                for (int wv = 0; wv < 8; ++wv) { s1 += red[(pb * 8 + wv) * 16 + 2 * tid]; s2 += red[(pb * 8 + wv) * 16 + 2 * tid + 1]; }
                const float mu = s1 * (1.f / 1024.f), var = fmaxf(s2 * (1.f / 1024.f) - mu * mu, 0.f);
                fin[pb * 8 + tid] = (f32x2){mu, 1.0f / sqrtf(var + pg8::kEPS)}; }
            __syncthreads();
#pragma unroll
            for (int i = 0; i < 8; ++i) { const f32x2 ms = fin[pb * 8 + i]; const f32x2 a = lg * ms.y, b = lb - a * ms.x; const f32x2 z = y[i] * a + b; const f32x2 gg = unpk(gcr[i]);
                const f32x2 t = z * (-pg8::kLOG2E); f32x2 d; d.x = __builtin_amdgcn_exp2f(t.x); d.y = __builtin_amdgcn_exp2f(t.y); d = d + 1.0f;
                f32x2 r; r.x = __builtin_amdgcn_rcpf(d.x); r.y = __builtin_amdgcn_rcpf(d.y);
                const f32x2 o = (z * r) * gg;
                *(unsigned*)(Op + (long)(ch * 8 + i) * 1024) = pg8::cvt_pk_bf16(o.x, o.y); }
#pragma unroll
            for (int i = 0; i < 30; ++i) asm("v_pk_mov_b32 %0, %1, %1 op_sel:[0,1]" : "=v"(win[i]) : "v"(win[i + 8]));
        }
    }
    __syncthreads();
}

__device__ __forceinline__ void build_bias_table(const float* LF, const float* gq, const float* gk, int bh, LAS unsigned char* lds, int tid, int wave, int lane) {
    LAS v4u* tab = (LAS v4u*)(lds + BT_OFF); LAS float* wtot = (LAS float*)(lds + WT_OFF); LAS float* te = (LAS float*)(lds + WT_OFF + 256);
    const int b = bh >> 4, h = bh & 15;
    const float* lf = LF + (size_t)b * SEQ * 16 + h;
    const int t0 = 4 * tid; float v[4];
#pragma unroll
    for (int i = 0; i < 4; ++i) v[i] = lf[(size_t)(t0 + i) * 16];
    v[1] += v[0]; v[2] += v[1]; v[3] += v[2];
    const float tot = v[3]; float inc = tot;
#pragma unroll
    for (int o = 1; o < 64; o <<= 1) { const float n = __shfl_up(inc, o); if (lane >= o) inc += n; }
    if (lane == 63) wtot[wave] = inc;
    __syncthreads();
    float off = inc - tot;
    for (int wv = 0; wv < wave; ++wv) off += wtot[wv];
#pragma unroll
    for (int i = 0; i < 4; ++i) { const float bias = -(v[i] + off) * pg8::kLOG2E;
        const unsigned b1 = f2bf(bias); const float r1 = bias - __uint_as_float(b1 << 16);
        const unsigned b2 = f2bf(r1);   const float r2 = r1 - __uint_as_float(b2 << 16);
        const unsigned b3 = f2bf(r2);
        tab[t0 + i] = (v4u){b1 | (b2 << 16), b3 | 0x3F800000u, 0x3F803F80u, 0u};
        if (i == 3 && (tid & 15) == 15) te[tid >> 4] = bias; }
    if (wave == 0) { float mq = fabsf(gq[h * 64 + lane]), mk = fabsf(gk[h * 64 + lane]);
#pragma unroll
        for (int o = 1; o < 64; o <<= 1) { mq = fmaxf(mq, __shfl_xor(mq, o)); mk = fmaxf(mk, __shfl_xor(mk, o)); }
        if (lane == 0) te[32] = 2.0f * (8.0f * pg8::kLOG2E * 1.03f * mq * mk) + 75.0f; }
    __syncthreads();
}
__global__ void __launch_bounds__(NWAVES * 64, 2) skel_fwd(Args args) {
    extern __shared__ __attribute__((aligned(16))) unsigned char lds_raw[];
    LAS unsigned char* lds = (LAS unsigned char*)lds_raw;
    const int G = gridDim.x, bx = blockIdx.x, vcu = (G % 8 == 0) ? (bx % 8) * (G / 8) + bx / 8 : bx;
#define PHASE_IDS() int tid = threadIdx.x; asm volatile("" : "+v"(tid)); const int lane = tid & 63, wave = __builtin_amdgcn_readfirstlane(tid >> 6); (void)lane; (void)wave
#define KARGS() ({ KArgs k_ = (KArgs)__builtin_amdgcn_kernarg_segment_ptr(); asm volatile("" : "+s"(k_)); k_; })
#if MK_N_LAUNCHES == 1
#define IN(k) true
#define GRID_BAR() xcd_barrier(bar)
#else
    const int lo = args.ph_lo, hi = args.ph_hi;
#define IN(k) (lo <= (k) && (k) < hi)
#define GRID_BAR() do {} while (0)
#endif

#if MK_N_LAUNCHES == 1
    if (threadIdx.x < 2) ((volatile LAS unsigned*)(lds + MISC_OFF))[threadIdx.x] = 0u;
    __syncthreads();
    XcdBarrier bar = xcd_barrier_post((unsigned*)(KARGS()->ws + WS_CTL), (volatile LAS unsigned*)(lds + MISC_OFF));
    if (KARGS()->ph_lo < 0) cg::this_grid().sync();
#endif
    if (IN(0)) { PHASE_IDS(); int nrep0 = (MK_PROBE == 1) ? 2 : 1; asm volatile("" : "+s"(nrep0));
#pragma unroll 1
        for (int r = 0; r < nrep0; ++r) { p0_prologue(KARGS(), lds, vcu, G, tid, wave, lane); __syncthreads(); }

 if (IN(1)) GRID_BAR(); }

    if (IN(1)) {
        KArgs Ap = KARGS(); unsigned char* ws = Ap->ws;
        pg8::Gemm g{(const bf16*)(ws + WS_XN), (const bf16*)(ws + WS_BT1), M, N1, DMODEL, DMODEL, 1 << 30, 0l}; pg8::StaticOrder S; S.init(M, N1, G, bx);
        pg8::Epi1 E{(bf16*)(ws + WS_Q), (const float*)(ws + WS_RS), Ap->in[4], Ap->in[5], lds + ESTG_OFF};
        int nrep1 = (MK_PROBE == 2) ? 2 : 1; asm volatile("" : "+s"(nrep1));
#pragma unroll 1
        for (int r = 0; r < nrep1; ++r) { pg8::gemm_phase<pg8::Epi1, pg8::StaticOrder, true, true>(lds, g, S, E); __syncthreads(); }
#if MK_N_LAUNCHES == 1
        { PHASE_IDS(); build_bias_table((const float*)(ws + WS_LF), Ap->in[4], Ap->in[5], vcu % (BATCH * NH), lds, tid, wave, lane); }
#endif
        if (IN(2)) GRID_BAR();
    }

    if (IN(2)) {
        { PHASE_IDS();
        unsigned char* ws = KARGS()->ws;
        const attn_body::bf16* QB = (const attn_body::bf16*)(ws + WS_Q);
        int cur_bh = (MK_N_LAUNCHES == 1) ? vcu % (BATCH * NH) : -1;
        int pass0 = (MK_PROBE == 4) ? 0 : 1; asm volatile("" : "+s"(pass0));
#pragma unroll 1
        for (int pass = pass0; pass < 2; ++pass)
        for (int L = vcu; L < BATCH * NH * (SEQ / 256); L += G) {
            const int bh = L % (BATCH * NH), qb = L / (BATCH * NH);
            if (bh != cur_bh) { KArgs Aq = KARGS(); build_bias_table((const float*)(ws + WS_LF), Aq->in[4], Aq->in[5], bh, lds, tid, wave, lane); cur_bh = bh; }
            int ts = 0;
            if (qb > 0) { const LAS float* te = (const LAS float*)(lds + WT_OFF + 256); const float ref = te[4 * qb - 1], th = te[32];
                const bool c = lane < 32 && lane < 4 * qb && (ref - te[lane & 31] > th); ts = (int)__popcll(__ballot(c)) & ~1; }
            ts = __builtin_amdgcn_readfirstlane(ts);
#ifndef NO_ATTN
            attn_body::attn_unit<96>(bh >> 4, bh & 15, qb, ts, QB, QB + pg8::Epi1::ZS, QB + 2 * pg8::Epi1::ZS, pass ? (attn_body::bf16*)QB : (attn_body::bf16*)(ws + WS_XN), QB + 3 * pg8::Epi1::ZS, (char*)lds_raw, (attn_body::lds_cptr)(lds + BT_OFF));
#endif
        }
        }
        __syncthreads();
#ifndef NO_CONV
        { PHASE_IDS(); conv_phase(KARGS(), lds, vcu, G, tid, wave, lane, WS_GC); }
#endif
        if (IN(3)) GRID_BAR();
    }

    if (IN(3)) {
        KArgs Ap = KARGS(); unsigned char* ws = Ap->ws;
        pg8::Gemm g{(const bf16*)(ws + WS_Q), (const bf16*)(ws + WS_BT2), M, DMODEL, K2, DMODEL, 16, (long)(WS_GC - WS_Q) - 16l * 128l}; pg8::StaticOrder S; S.init(M, DMODEL, G, bx);
        pg8::Epi2 E{Ap->in[0], Ap->out, lds + ESTG_OFF};
        int nrep3 = (MK_PROBE == 5) ? 2 : 1; asm volatile("" : "+s"(nrep3));
#pragma unroll 1
        for (int r = 0; r < nrep3; ++r) { pg8::gemm_phase<pg8::Epi2, pg8::StaticOrder, true, true>(lds, g, S, E); __syncthreads(); }
    }
#undef KARGS
#undef IN
}

extern "C" void kernel_launch(void* const* d_in, const int* in_sizes, int n_in, void* d_out, int out_size, void* d_ws, size_t ws_size, hipStream_t stream) {
    static int grid = 0;
    if (grid == 0) {
        if (n_in != 11 || in_sizes[0] != M * DMODEL || out_size != M * DMODEL || ws_size < WS_END) { fprintf(stderr, "kernel_launch: shape/workspace mismatch (n_in %d, in0 %d, out %d, ws %zu)\n", n_in, n_in > 0 ? in_sizes[0] : -1, out_size, ws_size); grid = -1; return; }
        int dev = 0, cus = 0, per_cu = 0;
        if (hipGetDevice(&dev) != hipSuccess || hipDeviceGetAttribute(&cus, hipDeviceAttributeMultiprocessorCount, dev) != hipSuccess) { grid = -1; return; }
        if (hipFuncSetAttribute((const void*)skel_fwd, hipFuncAttributeMaxDynamicSharedMemorySize, LDS_BYTES) != hipSuccess) { fprintf(stderr, "kernel_launch: hipFuncSetAttribute failed\n"); grid = -1; return; }
        if (hipOccupancyMaxActiveBlocksPerMultiprocessor(&per_cu, (const void*)skel_fwd, NWAVES * 64, LDS_BYTES) != hipSuccess || per_cu < 1) { fprintf(stderr, "kernel_launch: occupancy query says %d blocks per CU\n", per_cu); per_cu = 1; }
        (void)hipGetLastError();
        grid = cus;
    }
    if (grid < 0) return;
    if (hipMemsetAsync((char*)d_ws + WS_CTL, 0, CTL_ZERO_BYTES, stream) != hipSuccess) { fprintf(stderr, "kernel_launch: hipMemsetAsync failed\n"); return; }
    Args a{};
    for (int i = 0; i < 11; ++i) a.in[i] = (const float*)d_in[i];
    a.out = (float*)d_out; a.ws = (unsigned char*)d_ws;
#if MK_N_LAUNCHES == 1
    a.ph_lo = 0; a.ph_hi = 4;
    void* kargs[] = {&a};
    hipError_t e = hipLaunchCooperativeKernel((const void*)skel_fwd, dim3(grid), dim3(NWAVES * 64), kargs, LDS_BYTES, stream);
    if (e != hipSuccess) fprintf(stderr, "cooperative launch failed: %s (grid %d)\n", hipGetErrorString(e), grid);
#else
    for (int p = 0; p < 4; ++p) { a.ph_lo = p; a.ph_hi = p + 1; hipLaunchKernelGGL(skel_fwd, dim3(grid), dim3(NWAVES * 64), LDS_BYTES, stream, a); }
#endif
}
```

```cpp
#include <hip/hip_runtime.h>
#include <hip/hip_cooperative_groups.h>
#include <cstdio>
#include <cstdint>
namespace cg = cooperative_groups;
#ifndef MK_PROBE
#define MK_PROBE 0
#endif
#ifndef MK_N_LAUNCHES
#define MK_N_LAUNCHES 1
#endif
namespace pg8 {
#define PG8_LAS __attribute__((address_space(3)))
typedef unsigned short bf16_t;
typedef short bf16x8 __attribute__((ext_vector_type(8)));
typedef float f32x4 __attribute__((ext_vector_type(4)));
typedef unsigned u32x4 __attribute__((ext_vector_type(4)));
constexpr int BM = 256, BK = 64, HALF = 128, HTB = HALF * BK * 2  , STAGE_BYTES = 8 * HTB, NXCD = 8, WGM = 2;

__host__ __device__ __forceinline__ int lds_byte(int r, int c) { const int st = (r >> 4) * 2 + (c >> 5), rr = r & 15, cc = c & 31, ob = rr * 64 + cc * 2; return st * 1024 + (ob ^ (((ob >> 9) & 1) << 5)); }
__host__ __device__ __forceinline__ void stage_rc(int b, int& R, int& C) { const int st = b / 1024, sb = b % 1024, swz = sb ^ (((sb >> 9) & 1) << 5); R = (st >> 1) * 16 + swz / 64; C = (st & 1) * 32 + (swz % 64) / 2; }
__host__ __device__ __forceinline__ int perm32(int rho) { const int n = rho >> 4, i = rho & 15; return 8 * (i >> 2) + 4 * n + (i & 3); }

struct Unit { int pm, pn; };
struct Gemm { const bf16_t* A; const bf16_t* Bt; int M, N, K; int lda; int ksplit; long ajump; };

struct StaticOrder {
    int nM, nN, nwg, G, c;
    __host__ __device__ void init(int M, int N, int G_, int c_) { nM = M / BM; nN = N / BM; nwg = nM * nN; G = G_; c = c_; }
    __host__ __device__ bool next(int i, Unit& u) const {
        const long L = (long)i * G + c; if (L >= nwg) return false;
        int wgid = (int)L; { const int q = nwg / NXCD, r = nwg % NXCD, xcd = wgid % NXCD, off = wgid / NXCD; wgid = (xcd < r ? xcd * (q + 1) : r * (q + 1) + (xcd - r) * q) + off; }
        const int nig = WGM * nN, gid = wgid / nig, fm = gid * WGM, gsz = (nM - fm) < WGM ? (nM - fm) : WGM;
        u.pm = fm + ((wgid % nig) % gsz); u.pn = (wgid % nig) / gsz; return true;
    }
    __device__ __forceinline__ void a_ready(const Unit&) const {}
    __device__ __forceinline__ void done(const Unit&) const {}
};
typedef __bf16 bf16x2v __attribute__((ext_vector_type(2)));
typedef float f32x2 __attribute__((ext_vector_type(2)));
__device__ __forceinline__ unsigned cvt_pk_bf16(float lo, float hi) { const f32x2 v = {lo, hi}; return __builtin_bit_cast(unsigned, __builtin_convertvector(v, bf16x2v)); }
constexpr float kEPS = 1e-6f, kLOG2E = 1.4426950408889634f, kC2 = 0.125f * 1.4426950408889634f;
__device__ __forceinline__ float sigmoid_f(float x) { return __builtin_amdgcn_rcpf(1.0f + __builtin_amdgcn_exp2f(-kLOG2E * x)); }
__device__ __forceinline__ f32x4 sigmoid4(f32x4 x) { const f32x4 t = x * (-kLOG2E); f32x4 e; e[0] = __builtin_amdgcn_exp2f(t[0]); e[1] = __builtin_amdgcn_exp2f(t[1]); e[2] = __builtin_amdgcn_exp2f(t[2]); e[3] = __builtin_amdgcn_exp2f(t[3]);
    e = e + 1.0f; f32x4 r; r[0] = __builtin_amdgcn_rcpf(e[0]); r[1] = __builtin_amdgcn_rcpf(e[1]); r[2] = __builtin_amdgcn_rcpf(e[2]); r[3] = __builtin_amdgcn_rcpf(e[3]); return r; }
__device__ __forceinline__ u32x4 pack8(f32x4 v0, f32x4 v1) { u32x4 w; w.x = cvt_pk_bf16(v0[0], v0[1]); w.y = cvt_pk_bf16(v0[2], v0[3]); w.z = cvt_pk_bf16(v1[0], v1[1]); w.w = cvt_pk_bf16(v1[2], v1[3]); return w; }
struct Epi1 {
    static constexpr bool PERM = true, AFTER_DRAIN = false;
    bf16_t* Z; const float* RS; const float *qg, *kg; PG8_LAS unsigned char* stg;
    static constexpr size_t ZS = (size_t)32 << 20;
    __device__ __forceinline__ void operator()(const f32x4 (&acc)[2][2][4][2], const Unit& u, int wr, int wc, int fr, int fq) const {
        const int pn = u.pn; const int row0 = u.pm * BM + wr * 64 + fr;
        float rsv[2][4];
#pragma unroll
        for (int ai = 0; ai < 2; ++ai)
#pragma unroll
            for (int m = 0; m < 4; ++m) rsv[ai][m] = RS[row0 + ai * HALF + m * 16];
        const int l_ = fr + 16 * fq, rr_ = l_ >> 3, cc_ = l_ & 7;
        PG8_LAS unsigned char* slab = stg + (wr * 4 + wc) * 2304;
        PG8_LAS u32x4* wp = (PG8_LAS u32x4*)(slab + fr * 144 + fq * 16); const PG8_LAS u32x4* rp = (const PG8_LAS u32x4*)(slab + rr_ * 144 + cc_ * 16);
        const size_t rowst = (size_t)(u.pm * BM + wr * 64 + rr_) * 1024;
#define EPI1_STORE128(basep, colw, AI, MM, W0, W1) do { wp[0] = (W0); wp[4] = (W1); asm volatile("s_waitcnt lgkmcnt(0)" ::: "memory"); const u32x4 a_ = rp[0], b_ = rp[72]; asm volatile("s_waitcnt lgkmcnt(0)" ::: "memory"); \
            bf16_t* d_ = (basep) + rowst + (size_t)((AI) * HALF + (MM) * 16) * 1024 + (colw) + 8 * cc_; *(u32x4*)d_ = a_; *(u32x4*)(d_ + 8 * 1024) = b_; } while (0)
        if (pn < 8) {
            const bool isq = pn < 4; const int sec = isq ? pn : pn - 4;
            bf16_t* base = Z + (isq ? 0 : ZS); const float* gp = (isq ? qg : kg) + (sec * 4 + wc) * 64 + 8 * fq; const float sc = isq ? kC2 : 1.0f;
            f32x4 g[2][2];
#pragma unroll
            for (int bj = 0; bj < 2; ++bj)
#pragma unroll
                for (int n = 0; n < 2; ++n) g[bj][n] = *(const f32x4*)(gp + 32 * bj + 4 * n) * sc;
#pragma unroll
            for (int ai = 0; ai < 2; ++ai)
#pragma unroll
                for (int m = 0; m < 4; ++m) {
                    float ss = 0.f;
#pragma unroll
                    for (int bj = 0; bj < 2; ++bj)
#pragma unroll
                        for (int n = 0; n < 2; ++n) { const f32x4 x = acc[ai][bj][m][n]; ss += (x[0] * x[0] + x[1] * x[1]) + (x[2] * x[2] + x[3] * x[3]); }
                    ss += __shfl_xor(ss, 16); ss += __shfl_xor(ss, 32);
                    const float rs = rsv[ai][m];
                    const float rinv = rs * __builtin_amdgcn_rsqf(ss * rs * rs * (1.0f / 64.0f) + kEPS);
                    const u32x4 w0 = pack8(acc[ai][0][m][0] * rinv * g[0][0], acc[ai][0][m][1] * rinv * g[0][1]), w1 = pack8(acc[ai][1][m][0] * rinv * g[1][0], acc[ai][1][m][1] * rinv * g[1][1]);
                    EPI1_STORE128(base, sec * 256 + wc * 64, ai, m, w0, w1);
                }
        } else if (pn < 16 || pn >= 24) {
            const bool act = pn >= 12; const int sec = pn < 12 ? pn - 8 : (pn < 16 ? pn - 12 : pn - 24);
            bf16_t* base = Z + (size_t)(pn < 12 ? 2 : (pn < 16 ? 3 : 5)) * ZS;
#pragma unroll
            for (int ai = 0; ai < 2; ++ai)
#pragma unroll
                for (int m = 0; m < 4; ++m) { const float rs = rsv[ai][m]; u32x4 w[2];
#pragma unroll
                    for (int bj = 0; bj < 2; ++bj) { f32x4 v0 = acc[ai][bj][m][0] * rs, v1 = acc[ai][bj][m][1] * rs;
                        if (act) { v0 = v0 * sigmoid4(v0); v1 = v1 * sigmoid4(v1); }
                        w[bj] = pack8(v0, v1); }
                    EPI1_STORE128(base, sec * 256 + wc * 64, ai, m, w[0], w[1]); }
        } else {
            const int r4 = l_ >> 2, c4 = l_ & 3; const PG8_LAS u32x4* rp4 = (const PG8_LAS u32x4*)(slab + r4 * 144 + c4 * 16);
            bf16_t* ub = Z + 4 * ZS + (size_t)(u.pm * BM + wr * 64 + r4) * 1024 + (pn - 16) * 128 + wc * 32 + 8 * c4;
#pragma unroll
            for (int ai = 0; ai < 2; ++ai)
#pragma unroll
                for (int m = 0; m < 4; ++m) { const float rs = rsv[ai][m]; f32x4 v0 = acc[ai][0][m][0] * rs, v1 = acc[ai][0][m][1] * rs; const f32x4 g0 = acc[ai][1][m][0] * rs, g1 = acc[ai][1][m][1] * rs;
                    v0 = v0 * sigmoid4(g0); v1 = v1 * sigmoid4(g1);
                    wp[0] = pack8(v0, v1); asm volatile("s_waitcnt lgkmcnt(0)" ::: "memory"); const u32x4 a_ = rp4[0]; asm volatile("s_waitcnt lgkmcnt(0)" ::: "memory");
                    *(u32x4*)(ub + (size_t)(ai * HALF + m * 16) * 1024) = a_; }
        }
#undef EPI1_STORE128
    }
};
struct Epi2 {
    static constexpr bool PERM = true, AFTER_DRAIN = false;
    const float* __restrict__ x; float* __restrict__ out; PG8_LAS unsigned char* stg;
    __device__ __forceinline__ void operator()(const f32x4 (&acc)[2][2][4][2], const Unit& u, int wr, int wc, int fr, int fq) const {
        const int l = fr + 16 * fq, rr = l >> 3, cc = l & 7;
        PG8_LAS unsigned char* slab = stg + (wr * 4 + wc) * 2304;
        PG8_LAS f32x4* wp = (PG8_LAS f32x4*)(slab + fr * 144 + fq * 32); const PG8_LAS f32x4* rp = (const PG8_LAS f32x4*)(slab + rr * 144 + cc * 16);
        const size_t g0 = (size_t)(u.pm * BM + wr * 64 + rr) * 1024 + u.pn * BM + wc * 32 + 4 * cc;
        const float* __restrict__ xb = x + g0; float* __restrict__ ob = out + g0;
#pragma unroll
        for (int ai = 0; ai < 2; ++ai) {
            f32x4 pre[4][2][2];
#pragma unroll
            for (int m = 0; m < 4; ++m)
#pragma unroll
                for (int bj = 0; bj < 2; ++bj)
#pragma unroll
                    for (int r = 0; r < 2; ++r) pre[m][bj][r] = *(const f32x4*)(xb + (size_t)(ai * HALF + m * 16 + 8 * r) * 1024 + bj * HALF);
            asm volatile("" ::: "memory");
#pragma unroll
            for (int m = 0; m < 4; ++m)
#pragma unroll
                for (int bj = 0; bj < 2; ++bj) {
                    wp[0] = acc[ai][bj][m][0]; wp[1] = acc[ai][bj][m][1];
                    asm volatile("s_waitcnt lgkmcnt(0)" ::: "memory");
                    const f32x4 v0 = rp[0], v1 = rp[8 * 9];
                    asm volatile("s_waitcnt lgkmcnt(0)" ::: "memory");
                    *(f32x4*)(ob + (size_t)(ai * HALF + m * 16) * 1024 + bj * HALF) = pre[m][bj][0] + v0;
                    *(f32x4*)(ob + (size_t)(ai * HALF + m * 16 + 8) * 1024 + bj * HALF) = pre[m][bj][1] + v1;
                }
            asm volatile("" ::: "memory");
        }
    }
};
template <class Epi, class Sched, bool ALIGN_EPI = false, bool SP2 = false>
__device__ __forceinline__ void gemm_phase(PG8_LAS unsigned char* lds, const Gemm g, const Sched& S, const Epi& E) {
    int tid_ = threadIdx.x; asm volatile("" : "+v"(tid_));
    const int tid = tid_, wid = __builtin_amdgcn_readfirstlane(tid >> 6), lane = tid & 63, wr = wid >> 2, wc = wid & 3, fr = lane & 15, fq = lane >> 4;
    const int K = g.K, nt = K / BK;
    unsigned voffA[2], voffB[2];
#pragma unroll
    for (int i = 0; i < 2; ++i) { int R, C; stage_rc(tid * 16 + i * 8192, R, C); const int Rb = Epi::PERM ? ((R & ~31) + perm32(R & 31)) : R;
        voffA[i] = (unsigned)(R * g.lda + C) * 2u; voffB[i] = (unsigned)(Rb * K + C) * 2u; }
    const size_t kstep = (size_t)(BK * 2);
    const size_t hstepA = (size_t)HALF * g.lda * 2, hstepB = (size_t)HALF * K * 2;
    const size_t tstepA = 2 * hstepA, tstepB = 2 * hstepB;
    const int ksplit = g.ksplit; const long ajump = g.ajump;
#define PG8_KOFF(t) ((size_t)(t) * kstep + ((t) >= ksplit ? ajump : 0l))
    const unsigned ldsw = (unsigned)wid * 1024u;
    const int aoff = lds_byte(wr * 64 + fr, fq * 8), boff = lds_byte(wc * 32 + fr, fq * 8);
#define PG8_SA(b, h) (((b) * 2 + (h)) * HTB)
#define PG8_SB(b, h) ((4 + (b) * 2 + (h)) * HTB)
#define PG8_STAGE(bufoff, gbase, voff) do { _Pragma("unroll") for (int _i = 0; _i < 2; ++_i) \
        __builtin_amdgcn_global_load_lds((const unsigned*)((const char*)(gbase) + (voff)[_i]), (PG8_LAS unsigned*)(lds + (bufoff) + ldsw + _i * 8192), 16, 0, 0); } while (0)
#define PG8_LDA(dst, b, h) do { _Pragma("unroll") for (int m = 0; m < 4; ++m) _Pragma("unroll") for (int k = 0; k < 2; ++k) dst[m][k] = *(const PG8_LAS bf16x8*)(lds + PG8_SA(b, h) + aoff + m * 2048 + k * 1024); } while (0)
#define PG8_LDB(dst, b, h) do { _Pragma("unroll") for (int n = 0; n < 2; ++n) _Pragma("unroll") for (int k = 0; k < 2; ++k) dst[n][k] = *(const PG8_LAS bf16x8*)(lds + PG8_SB(b, h) + boff + n * 2048 + k * 1024); } while (0)
#define PG8_MMA(ai, bj, At, Bt) do { __builtin_amdgcn_s_setprio(1); _Pragma("unroll") for (int m = 0; m < 4; ++m) _Pragma("unroll") for (int n = 0; n < 2; ++n) _Pragma("unroll") for (int k = 0; k < 2; ++k) \
        acc[ai][bj][m][n] = __builtin_amdgcn_mfma_f32_16x16x32_bf16(Bt[n][k], At[m][k], acc[ai][bj][m][n], 0, 0, 0); __builtin_amdgcn_s_setprio(0); } while (0)
#define PG8_WAIT_V(n) asm volatile("s_waitcnt vmcnt(" #n ")" ::: "memory")
#define PG8_WAIT_L(n) asm volatile("s_waitcnt lgkmcnt(" #n ")" ::: "memory")
#define PG8_BAR __builtin_amdgcn_s_barrier()
#define PG8_SCHED __builtin_amdgcn_sched_barrier(0)
    Unit cur, nxt; int ui = 0;
    if (!S.next(0, cur)) return;
    f32x4 acc[2][2][4][2];
#pragma unroll
    for (int a = 0; a < 2; ++a)
#pragma unroll
        for (int b = 0; b < 2; ++b)
#pragma unroll
            for (int m = 0; m < 4; ++m)
#pragma unroll
                for (int n = 0; n < 2; ++n) acc[a][b][m][n] = (f32x4){0.f, 0.f, 0.f, 0.f};
    bf16x8 At[4][2], B0[2][2], B1[2][2];
    const char* cA = (const char*)g.A + (size_t)cur.pm * tstepA; const char* cB = (const char*)g.Bt + (size_t)cur.pn * tstepB;
    S.a_ready(cur);
    if constexpr (SP2) {
        PG8_STAGE(PG8_SB(0, 0), cB, voffB); PG8_STAGE(PG8_SB(0, 1), cB + hstepB, voffB); PG8_STAGE(PG8_SA(0, 0), cA, voffA); PG8_STAGE(PG8_SA(0, 1), cA + hstepA, voffA);
        if (wr == 1) PG8_BAR;
        PG8_WAIT_V(2); PG8_BAR;
        PG8_STAGE(PG8_SB(1, 0), cB + kstep, voffB); PG8_STAGE(PG8_SA(1, 0), cA + kstep, voffA); PG8_STAGE(PG8_SB(1, 1), cB + hstepB + kstep, voffB);
        PG8_WAIT_V(6); PG8_BAR;
    } else {
        PG8_STAGE(PG8_SB(0, 0), cB, voffB); PG8_STAGE(PG8_SA(0, 0), cA, voffA); PG8_STAGE(PG8_SB(0, 1), cB + hstepB, voffB); PG8_STAGE(PG8_SA(0, 1), cA + hstepA, voffA);
        if (wr == 1) PG8_BAR;
        PG8_WAIT_V(4); PG8_BAR;
        PG8_STAGE(PG8_SB(1, 0), cB + kstep, voffB); PG8_STAGE(PG8_SA(1, 0), cA + kstep, voffA); PG8_STAGE(PG8_SB(1, 1), cB + hstepB + kstep, voffB);
        PG8_WAIT_V(6); PG8_BAR;
    }
    for (;;) {
        const bool has_next = S.next(ui + 1, nxt);
        const char* nA = has_next ? (const char*)g.A + (size_t)nxt.pm * tstepA : cA; const char* nB = has_next ? (const char*)g.Bt + (size_t)nxt.pn * tstepB : cB;
        for (int t = 0; t < nt; t += 2) {
            const bool last = (t == nt - 2);
            const char* a1 = cA + PG8_KOFF(t + 1);
            const char* a2 = last ? nA : cA + PG8_KOFF(t + 2); const char* b2 = last ? nB : cB + (size_t)(t + 2) * kstep;
            const char* a3 = a2 + kstep; const char* b3 = b2 + kstep;
            if (last && has_next) S.a_ready(nxt);
            if constexpr (SP2) {
            PG8_LDB(B0, 0, 0); PG8_LDB(B1, 0, 1); PG8_SCHED; PG8_LDA(At, 0, 0); PG8_STAGE(PG8_SA(1, 1), a1 + hstepA, voffA);
            PG8_WAIT_V(8); PG8_WAIT_L(0); PG8_BAR; PG8_MMA(0, 0, At, B0); PG8_MMA(0, 1, At, B1); PG8_BAR; PG8_SCHED;
            PG8_LDA(At, 0, 1); PG8_STAGE(PG8_SB(0, 0), b2, voffB); PG8_STAGE(PG8_SB(0, 1), b2 + hstepB, voffB); PG8_STAGE(PG8_SA(0, 0), a2, voffA);
            PG8_WAIT_V(8); PG8_WAIT_L(0); PG8_BAR; PG8_MMA(1, 0, At, B0); PG8_MMA(1, 1, At, B1); PG8_BAR; PG8_SCHED;
            PG8_LDB(B0, 1, 0); PG8_LDB(B1, 1, 1); PG8_SCHED; PG8_LDA(At, 1, 0); PG8_STAGE(PG8_SA(0, 1), a2 + hstepA, voffA);
            PG8_WAIT_V(8); PG8_WAIT_L(0); PG8_BAR; PG8_MMA(0, 0, At, B0); PG8_MMA(0, 1, At, B1); PG8_BAR; PG8_SCHED;
            PG8_LDA(At, 1, 1); PG8_STAGE(PG8_SB(1, 0), b3, voffB); PG8_STAGE(PG8_SB(1, 1), b3 + hstepB, voffB); PG8_STAGE(PG8_SA(1, 0), a3, voffA);
            PG8_WAIT_V(8); PG8_WAIT_L(0); PG8_BAR; PG8_MMA(1, 0, At, B0); PG8_MMA(1, 1, At, B1); PG8_BAR; PG8_SCHED;
            } else {
            PG8_LDB(B0, 0, 0); PG8_SCHED; PG8_LDA(At, 0, 0); PG8_STAGE(PG8_SA(1, 1), a1 + hstepA, voffA);
            PG8_WAIT_L(8); PG8_BAR; PG8_WAIT_L(0); PG8_MMA(0, 0, At, B0); PG8_BAR; PG8_SCHED;
            PG8_LDB(B1, 0, 1); PG8_STAGE(PG8_SB(0, 0), b2, voffB);
            PG8_BAR; PG8_WAIT_L(0); PG8_MMA(0, 1, At, B1); PG8_BAR;
            PG8_LDA(At, 0, 1); PG8_STAGE(PG8_SA(0, 0), a2, voffA);
            PG8_BAR; PG8_WAIT_L(0); PG8_MMA(1, 0, At, B0); PG8_BAR; PG8_SCHED;
            PG8_STAGE(PG8_SB(0, 1), b2 + hstepB, voffB);
            PG8_WAIT_V(6); PG8_BAR; PG8_MMA(1, 1, At, B1); PG8_BAR;
            PG8_LDB(B0, 1, 0); PG8_SCHED; PG8_LDA(At, 1, 0); PG8_STAGE(PG8_SA(0, 1), a2 + hstepA, voffA);
            PG8_WAIT_L(8); PG8_BAR; PG8_WAIT_L(0); PG8_MMA(0, 0, At, B0); PG8_BAR; PG8_SCHED;
            PG8_LDB(B1, 1, 1); PG8_STAGE(PG8_SB(1, 0), b3, voffB);
            PG8_BAR; PG8_WAIT_L(0); PG8_MMA(0, 1, At, B1); PG8_BAR;
            PG8_LDA(At, 1, 1); PG8_STAGE(PG8_SA(1, 0), a3, voffA);
            PG8_BAR; PG8_WAIT_L(0); PG8_MMA(1, 0, At, B0); PG8_BAR; PG8_SCHED;
            PG8_STAGE(PG8_SB(1, 1), b3 + hstepB, voffB);
            PG8_WAIT_V(6); PG8_BAR; PG8_MMA(1, 1, At, B1); PG8_BAR;
            }
        }
        if constexpr (ALIGN_EPI) { if (wr == 0) PG8_BAR; }
        if constexpr (!Epi::AFTER_DRAIN) { E(acc, cur, wr, wc, fr, fq); S.done(cur); }
        if (!has_next) break;
#pragma unroll
        for (int a = 0; a < 2; ++a)
#pragma unroll
            for (int b = 0; b < 2; ++b)
#pragma unroll
                for (int m = 0; m < 4; ++m)
#pragma unroll
                    for (int n = 0; n < 2; ++n) acc[a][b][m][n] = (f32x4){0.f, 0.f, 0.f, 0.f};
        cur = nxt; cA = nA; cB = nB; ++ui;
        if constexpr (ALIGN_EPI) { if (wr == 1) PG8_BAR; }
    }
    PG8_WAIT_V(0);
    if constexpr (!ALIGN_EPI) { if (wr == 0) PG8_BAR; }
    PG8_BAR;
    if constexpr (Epi::AFTER_DRAIN) { E.fused(acc, cur, wr, wc, fr, fq, lds, wid, lane); S.done(cur); }
#undef PG8_SA
#undef PG8_KOFF
#undef PG8_SB
#undef PG8_STAGE
#undef PG8_LDA
#undef PG8_LDB
#undef PG8_MMA
#undef PG8_WAIT_V
#undef PG8_WAIT_L
#undef PG8_BAR
#undef PG8_SCHED
}
}
#include <hip/hip_bf16.h>
#include <cmath>
namespace attn_body {
using bf16=__hip_bfloat16;
using bf16x8=__attribute__((ext_vector_type(8)))short;
using s16x4=__attribute__((ext_vector_type(4)))short;
using f32x16=__attribute__((ext_vector_type(16)))float;
using u32x4=__attribute__((ext_vector_type(4)))unsigned;
constexpr int BATCH=16,NHEAD=16,SEQ=2048,D=64,DM=NHEAD*D;
constexpr int NW=8,QBLK=32,QB=QBLK*NW,KVBLK=64,NQB=SEQ/QB;
constexpr int ATTN_PITCH=DM, ATTN_UNIT_ROWS=QB;
__device__ __forceinline__ int crow(int r,int hi){return (r&3)+8*(r>>2)+4*hi;}
#define SBAR() __builtin_amdgcn_sched_barrier(0)
__device__ __forceinline__ void cmask(f32x16&p0,f32x16&p1,int jb,int qrel,int hi){
  const float NEG=-INFINITY; int kb=64*jb+4*hi;
  #pragma unroll
  for(int r=0;r<16;++r){int kv=kb+(r&3)+8*(r>>2); if(kv>qrel)p0[r]=NEG; if(kv+32>qrel)p1[r]=NEG;}
}

constexpr int NSLOT=3, SLOTB=8192;
constexpr int LDS_K=0, LDS_V=NSLOT*SLOTB, LDS_WS=2*NSLOT*SLOTB, LDS_OST=LDS_WS+NW*64*4, LDS_BYTES=LDS_OST+NW*4096;
constexpr float C2=0.125f*1.4426950408889634f;
__device__ __forceinline__ void glds16(const void*gsrc,unsigned lds_dst){unsigned keep;
  asm volatile("s_mov_b32 %0, m0\n\ts_mov_b32 m0, %2\n\ts_nop 0\n\tglobal_load_lds_dwordx4 %1, off\n\ts_mov_b32 m0, %0":"=&s"(keep):"v"(gsrc),"s"(lds_dst):"memory");}
__device__ __forceinline__ float max3f(float a,float b,float c){float r;asm("v_max3_f32 %0, %1, %2, %3":"=v"(r):"v"(a),"v"(b),"v"(c));return r;}
__device__ __forceinline__ float max2f(float a,float b){float r;asm("v_max_f32_e32 %0, %1, %2":"=v"(r):"v"(a),"v"(b));return r;}
__device__ __forceinline__ float fadd_s(float a,float b){float r;asm("v_add_f32_e32 %0, %1, %2":"=v"(r):"v"(a),"v"(b));return r;}
__device__ __forceinline__ float fsub_s(float a,float b){float r;asm("v_sub_f32_e32 %0, %1, %2":"=v"(r):"v"(a),"v"(b));return r;}
typedef float f32x2_t __attribute__((ext_vector_type(2))); typedef __bf16 bf16x2_t __attribute__((ext_vector_type(2)));
__device__ __forceinline__ unsigned cvtpk_s(float lo,float hi){f32x2_t v={lo,hi};bf16x2_t b=__builtin_convertvector(v,bf16x2_t);return __builtin_bit_cast(unsigned,b);}
#define WAIT_BAR(N) asm volatile("s_waitcnt vmcnt(" #N ") lgkmcnt(0)\n\ts_barrier":::"memory")

__device__ __forceinline__ void qkt(f32x16&p0,f32x16&p1,const char*Kslot,const bf16x8*qr,int r32,int hi,s16x4 ka0,s16x4 ka1,s16x4 qaug){
  const f32x16 zero=f32x16{};
  const char*kb=Kslot+hi*1024+r32*16;
  #pragma unroll
  for(int d0=0;d0<4;++d0){
    const bf16x8 b0=*reinterpret_cast<const bf16x8*>(kb+d0*2048);
    const bf16x8 b1=*reinterpret_cast<const bf16x8*>(kb+d0*2048+512);
    if(d0==0){p0=__builtin_amdgcn_mfma_f32_32x32x16_bf16(b0,qr[0],zero,0,0,0);p1=__builtin_amdgcn_mfma_f32_32x32x16_bf16(b1,qr[0],zero,0,0,0);}
    else{p0=__builtin_amdgcn_mfma_f32_32x32x16_bf16(b0,qr[d0],p0,0,0,0);p1=__builtin_amdgcn_mfma_f32_32x32x16_bf16(b1,qr[d0],p1,0,0,0);}}
  p0=__builtin_amdgcn_mfma_f32_32x32x8bf16_1k(ka0,qaug,p0,0,0,0);p1=__builtin_amdgcn_mfma_f32_32x32x8bf16_1k(ka1,qaug,p1,0,0,0);
}
typedef __attribute__((address_space(3))) const char* lds_cptr;
typedef short v4i16_t __attribute__((ext_vector_type(4)));
__device__ __forceinline__ void kload8(bf16x8*kf,lds_cptr kp){
  kf[0]=*(const __attribute__((address_space(3))) bf16x8*)(kp);      kf[1]=*(const __attribute__((address_space(3))) bf16x8*)(kp+512);
  kf[2]=*(const __attribute__((address_space(3))) bf16x8*)(kp+2048); kf[3]=*(const __attribute__((address_space(3))) bf16x8*)(kp+2560);
  kf[4]=*(const __attribute__((address_space(3))) bf16x8*)(kp+4096); kf[5]=*(const __attribute__((address_space(3))) bf16x8*)(kp+4608);
  kf[6]=*(const __attribute__((address_space(3))) bf16x8*)(kp+6144); kf[7]=*(const __attribute__((address_space(3))) bf16x8*)(kp+6656);
}
__device__ __forceinline__ void kload2(bf16x8*kf,lds_cptr kp,int j){ kf[2*j]=*(const __attribute__((address_space(3))) bf16x8*)(kp+j*2048); kf[2*j+1]=*(const __attribute__((address_space(3))) bf16x8*)(kp+j*2048+512); }
__device__ __forceinline__ s16x4 vtr(lds_cptr p){ return __builtin_bit_cast(s16x4,__builtin_amdgcn_ds_read_tr16_b64_v4i16((__attribute__((address_space(3))) v4i16_t*)p)); }
__device__ __forceinline__ float rowmax(const f32x16&p0,const f32x16&p1){
  float a=max3f(p0[0],p0[1],p1[0]),b=max3f(p0[2],p0[3],p1[1]);a=max3f(a,p1[2],p1[3]);
  #pragma unroll
  for(int r=4;r<16;r+=4){a=max3f(a,p0[r],p0[r+1]);b=max3f(b,p0[r+2],p0[r+3]);a=max3f(a,p1[r],p1[r+1]);b=max3f(b,p1[r+2],p1[r+3]);}
  const float m=max2f(a,b);
  auto rr=__builtin_amdgcn_permlane32_swap(__float_as_uint(m),__float_as_uint(m),false,false);
  return max2f(__uint_as_float(rr[0]),__uint_as_float(rr[1]));
}
__device__ __forceinline__ void pv(f32x16*o,int vb,bf16x8 pa0,bf16x8 pa1,bf16x8 pa2,bf16x8 pa3){
  #pragma unroll
  for(int d0=0;d0<2;++d0){s16x4 lo[4],hi[4];
    #pragma unroll
    for(int ks=0;ks<4;++ks){
      asm volatile("ds_read_b64_tr_b16 %0,%1 offset:%c2":"=&v"(lo[ks]):"v"(vb),"i"(d0*4096+ks*1024):"memory");
      asm volatile("ds_read_b64_tr_b16 %0,%1 offset:%c2":"=&v"(hi[ks]):"v"(vb),"i"(d0*4096+ks*1024+512):"memory");}
    asm volatile("s_waitcnt lgkmcnt(0)":::"memory");SBAR();
    #define PK(k) (bf16x8){lo[k][0],lo[k][1],lo[k][2],lo[k][3],hi[k][0],hi[k][1],hi[k][2],hi[k][3]}
    o[d0]=__builtin_amdgcn_mfma_f32_32x32x16_bf16(pa0,PK(0),o[d0],0,0,0);
    o[d0]=__builtin_amdgcn_mfma_f32_32x32x16_bf16(pa1,PK(1),o[d0],0,0,0);
    o[d0]=__builtin_amdgcn_mfma_f32_32x32x16_bf16(pa2,PK(2),o[d0],0,0,0);
    o[d0]=__builtin_amdgcn_mfma_f32_32x32x16_bf16(pa3,PK(3),o[d0],0,0,0);
    #undef PK
  }
}

#ifndef ATTN_STORE16
#define ATTN_STORE16(p,v) (*(u32x4*)(p)=(v))
#endif
template<int THRL> __device__ __forceinline__ void attn_unit(int b,int h,int qb,int ts,const bf16*Q,const bf16*__restrict__ K,const bf16*__restrict__ V,bf16*O,const bf16*__restrict__ GF,char*shm,lds_cptr btab){
  int tid_=threadIdx.x; asm volatile("":"+v"(tid_)); const int tid=tid_,lane=tid&63,r32=lane&31,hi=lane>>5; const int wid=__builtin_amdgcn_readfirstlane(tid>>6);
  const long rowbase=(long)b*SEQ; const int q0=qb*QB;
  const bf16*Qw=Q+(rowbase+q0+wid*QBLK)*DM+h*D;
  const bf16*Kh=K+(rowbase+(long)ts*KVBLK)*DM+h*D,*Vh=V+(rowbase+(long)ts*KVBLK)*DM+h*D;
  const unsigned lds0=(unsigned)(uintptr_t)shm;
  float*wsf=(float*)(shm+LDS_WS)+wid*64;
  const bf16*ksrc=Kh+(long)lane*DM+wid*8;
  const bf16*vsrc=Vh+(long)(16*(wid&3)+(lane>>2))*DM+(wid>>2)*32+(lane&3)*8;
  const unsigned kdst=lds0+LDS_K+wid*1024, vdst=lds0+LDS_V+wid*1024;
  #define DMA_K(t,slot) glds16(ksrc+(long)(t)*KVBLK*DM,(unsigned)__builtin_amdgcn_readfirstlane(kdst+(slot)))
  #define DMA_V(t,slot) glds16(vsrc+(long)(t)*KVBLK*DM,(unsigned)__builtin_amdgcn_readfirstlane(vdst+(slot)))
  const int vb0=(int)(lds0+LDS_V)+((lane>>4)&1)*32+(lane&3)*8+(4*hi+((lane&15)>>2))*64;
  const char*Kbase=shm+LDS_K; bf16x8 kf[8];
  const lds_cptr shm3=(lds_cptr)shm; const lds_cptr kp0=shm3+LDS_K+hi*1024+r32*16; const lds_cptr vp0=shm3+LDS_V+((lane>>4)&1)*32+(lane&3)*8+(4*hi+((lane&15)>>2))*64;
  const int NT=(q0+QB)/KVBLK-ts;
  DMA_K(0,0);DMA_V(0,0);DMA_K(1,SLOTB);
  bf16x8 qr[4];
  #pragma unroll
  for(int d0=0;d0<4;++d0)qr[d0]=*reinterpret_cast<const bf16x8*>(&Qw[(long)r32*DM+d0*16+hi*8]);
  typedef unsigned u32x2_t __attribute__((ext_vector_type(2)));
  const lds_cptr bt0=btab+ts*(KVBLK*16)+r32*16+hi*8;
  #define KAUG(t,half) __builtin_bit_cast(s16x4,*(const __attribute__((address_space(3))) u32x2_t*)(bt0+((t)*64+(half)*32)*16))
  u32x2_t qaw=hi?(u32x2_t){0u,0u}:(u32x2_t){0x3F803F80u,0x00003F80u};
  #define QAUG __builtin_bit_cast(s16x4,qaw)
  #define SETQ() do{ const float nm_=-mhat; const unsigned m1_=cvtpk_s(nm_,0.f)&0xffffu; const float r1_=nm_-__uint_as_float(m1_<<16); const unsigned m2_=cvtpk_s(r1_,0.f)&0xffffu; const float r2_=r1_-__uint_as_float(m2_<<16); \
    const unsigned m3_=cvtpk_s(r2_,0.f)&0xffffu; qaw=hi?(u32x2_t){m2_|(m3_<<16),0u}:(u32x2_t){0x3F803F80u,0x3F80u|(m1_<<16)}; }while(0)
  typedef unsigned u32x2_t __attribute__((ext_vector_type(2)));
  float mhat=0.f,l_reg=0.f;f32x16 o[2];o[0]=f32x16{};o[1]=f32x16{};const f32x16 zero16=f32x16{};
  const int qrel=wid*QBLK+r32;
  #define CMASK(P0,P1,t) do{int jb_=(t)-(NT-4); if(jb_>=0)cmask(P0,P1,jb_,qrel,hi);}while(0)
  bool resc=false;
  #define START(P0,P1) do{ const float rm=rowmax(P0,P1); resc=false; \
    { const float dl=rm; mhat=fadd_s(mhat,dl); \
      _Pragma("unroll") for(int r=0;r<16;++r){P0[r]=fsub_s(P0[r],dl);P1[r]=fsub_s(P1[r],dl);} \
      SETQ(); } \
    _Pragma("unroll") for(int r=0;r<16;++r)P0[r]=__builtin_amdgcn_exp2f(P0[r]); }while(0)
  #define RESC() do{ if(resc){ asm volatile("s_waitcnt lgkmcnt(0)":::"memory"); \
      _Pragma("unroll") for(int d_=0;d_<2;++d_) _Pragma("unroll") for(int r=0;r<16;++r)o[d_][r]*=wsf[crow(r,hi)]; } }while(0)
  f32x16 pA0,pA1,pB0,pB1;
  int sl_prev=0,sl_cur=0,sl_next=SLOTB;
  #define ROT() do{sl_prev=sl_cur;sl_cur=sl_next;sl_next=(sl_next==(NSLOT-1)*SLOTB)?0:sl_next+SLOTB;}while(0)
  DMA_K(2,2*SLOTB);
  WAIT_BAR(3);
  qkt(pA0,pA1,Kbase,qr,r32,hi,KAUG(0,0),KAUG(0,1),QAUG);asm volatile("s_nop 15\n\ts_nop 7":"+v"(pA0),"+v"(pA1));CMASK(pA0,pA1,0);
  START(pA0,pA1);
  _Pragma("unroll") for(int r=0;r<16;++r)pA1[r]=__builtin_amdgcn_exp2f(pA1[r]);
  WAIT_BAR(0);
  DMA_K(3,0);DMA_V(1,SLOTB);
  ROT();
  kload8(kf,kp0+sl_cur);
  WAIT_BAR(2);
  s16x4 vlo[8],vhi[8]; u32x4 pw0,pw1,pw2,pw3;
  #define PKW(P,B) cvtpk_s(P[B],P[B+1])
  #define PAF(k) __builtin_bit_cast(bf16x8,pw##k)
  #define VFR(i) (bf16x8){vlo[i][0],vlo[i][1],vlo[i][2],vlo[i][3],vhi[i][0],vhi[i][1],vhi[i][2],vhi[i][3]}
  #define PIN(x) asm volatile("":"+v"(x))
  #define MX3(a,b,c) __builtin_fmaxf(__builtin_fmaxf((a),(b)),(c))
  #define GAPA(MF,A0,A1,A2,A3,W0,W1,PW) do{ MF; sacc+=A0; sacc+=A1; sacc+=A2; sacc+=A3; PIN(sacc); W0; W1; PIN(PW); SBAR(); }while(0)
  #define EX(v) __builtin_amdgcn_exp2f(v)
  #define GAPB(MF,X,B) do{ MF; X[B]=EX(X[B]); X[B+1]=EX(X[B+1]); X[B+2]=EX(X[B+2]); X[B+3]=EX(X[B+3]); PIN(X); SBAR(); }while(0)
  #define VRD(i) do{ vlo[i]=vtr(vp_+(((i)>>2)*4096+((i)&3)*1024)); vhi[i]=vtr(vp_+(((i)>>2)*4096+((i)&3)*1024+512)); }while(0)
  #define KRD(G,j) do{ if(G){ kload2(kf,kp0+sl_next,j); SBAR(); } }while(0)
  #define STEP(C0,C1,P0,P1,t,GK,GV,GL) do{ SBAR(); \
    const lds_cptr vp_=vp0+sl_prev; const s16x4 ka0_=KAUG(t,0),ka1_=KAUG(t,1); \
    VRD(0); SBAR(); float sacc=(P0[0]+P0[1]); \
    GAPA(C0=__builtin_amdgcn_mfma_f32_32x32x16_bf16(kf[0],qr[0],zero16,0,0,0), P0[2],P0[3],P0[4],P0[5],     pw0[0]=PKW(P0,0), pw0[1]=PKW(P0,2), pw0); \
    VRD(4); SBAR(); GAPA(C1=__builtin_amdgcn_mfma_f32_32x32x16_bf16(kf[1],qr[0],zero16,0,0,0), P0[6],P0[7],P0[8],P0[9],     pw0[2]=PKW(P0,4), pw0[3]=PKW(P0,6), pw0); \
    VRD(1); SBAR(); GAPA(C0=__builtin_amdgcn_mfma_f32_32x32x16_bf16(kf[2],qr[1],C0,0,0,0),   P0[10],P0[11],P0[12],P0[13], pw1[0]=PKW(P0,8), pw1[1]=PKW(P0,10), pw1); \
    VRD(5); SBAR(); GAPA(C1=__builtin_amdgcn_mfma_f32_32x32x16_bf16(kf[3],qr[1],C1,0,0,0),   P0[14],P0[15],P1[0],P1[1],   pw1[2]=PKW(P0,12),pw1[3]=PKW(P0,14), pw1); \
    VRD(2); SBAR(); GAPA(C0=__builtin_amdgcn_mfma_f32_32x32x16_bf16(kf[4],qr[2],C0,0,0,0),   P1[2],P1[3],P1[4],P1[5],     pw2[0]=PKW(P1,0), pw2[1]=PKW(P1,2), pw2); \
    VRD(6); SBAR(); GAPA(C1=__builtin_amdgcn_mfma_f32_32x32x16_bf16(kf[5],qr[2],C1,0,0,0),   P1[6],P1[7],P1[8],P1[9],     pw2[2]=PKW(P1,4), pw2[3]=PKW(P1,6), pw2); \
    VRD(3); SBAR(); GAPA(C0=__builtin_amdgcn_mfma_f32_32x32x16_bf16(kf[6],qr[3],C0,0,0,0),   P1[10],P1[11],P1[12],P1[13], pw3[0]=PKW(P1,8), pw3[1]=PKW(P1,10), pw3); \
    VRD(7); SBAR(); GAPA(C1=__builtin_amdgcn_mfma_f32_32x32x16_bf16(kf[7],qr[3],C1,0,0,0),   P1[14],P1[15],0.f,0.f,       pw3[2]=PKW(P1,12),pw3[3]=PKW(P1,14), pw3); \
    C0=__builtin_amdgcn_mfma_f32_32x32x8bf16_1k(ka0_,QAUG,C0,0,0,0); C1=__builtin_amdgcn_mfma_f32_32x32x8bf16_1k(ka1_,QAUG,C1,0,0,0); \
    l_reg+=sacc; \
    if(GK){DMA_K((t)+3,sl_cur);} if(GV){DMA_V((t)+1,sl_next);} \
    CMASK(C0,C1,t); \
    { float a=MX3(C0[0],C0[1],C1[0]),b=MX3(C0[2],C0[3],C1[1]); a=MX3(a,C1[2],C1[3]); \
      _Pragma("unroll") for(int r=4;r<16;r+=4){a=MX3(a,C0[r],C0[r+1]);b=MX3(b,C0[r+2],C0[r+3]);a=MX3(a,C1[r],C1[r+1]);b=MX3(b,C1[r+2],C1[r+3]);} \
      float rm=__builtin_fmaxf(a,b); { auto rr=__builtin_amdgcn_permlane32_swap(__float_as_uint(rm),__float_as_uint(rm),false,false); rm=__builtin_fmaxf(__uint_as_float(rr[0]),__uint_as_float(rr[1])); } \
      resc=false; \
      if(__builtin_expect(__any(rm>(float)THRL),0)){ const float dl=__builtin_fmaxf(rm,0.f); mhat+=dl; \
        _Pragma("unroll") for(int r=0;r<16;++r){C0[r]-=dl;C1[r]-=dl;} \
        SETQ(); \
        const float f=__builtin_amdgcn_exp2f(-dl); l_reg*=f; if(hi==0)wsf[r32]=f; resc=true; } } \
    SBAR(); \
    GAPB(o[0]=__builtin_amdgcn_mfma_f32_32x32x16_bf16(PAF(0),VFR(0),o[0],0,0,0), C0,0); \
    GAPB(o[1]=__builtin_amdgcn_mfma_f32_32x32x16_bf16(PAF(0),VFR(4),o[1],0,0,0), C0,4); \
    KRD(GL,0); GAPB(o[0]=__builtin_amdgcn_mfma_f32_32x32x16_bf16(PAF(1),VFR(1),o[0],0,0,0), C0,8); \
    KRD(GL,1); GAPB(o[1]=__builtin_amdgcn_mfma_f32_32x32x16_bf16(PAF(1),VFR(5),o[1],0,0,0), C0,12); \
    KRD(GL,2); GAPB(o[0]=__builtin_amdgcn_mfma_f32_32x32x16_bf16(PAF(2),VFR(2),o[0],0,0,0), C1,0); \
    KRD(GL,3); GAPB(o[1]=__builtin_amdgcn_mfma_f32_32x32x16_bf16(PAF(2),VFR(6),o[1],0,0,0), C1,4); \
    GAPB(o[0]=__builtin_amdgcn_mfma_f32_32x32x16_bf16(PAF(3),VFR(3),o[0],0,0,0), C1,8); \
    GAPB(o[1]=__builtin_amdgcn_mfma_f32_32x32x16_bf16(PAF(3),VFR(7),o[1],0,0,0), C1,12); \
    }while(0)
  int t=1;
  #undef CMASK
  #define CMASK(P0,P1,t) do{}while(0)
  for(;t+5<NT;t+=2){
    STEP(pB0,pB1,pA0,pA1,t,true,true,true);     WAIT_BAR(2); RESC(); ROT();
    STEP(pA0,pA1,pB0,pB1,t+1,true,true,true);   WAIT_BAR(2); RESC(); ROT();
  }
  #undef CMASK
  #define CMASK(P0,P1,t) do{int jb_=(t)-(NT-4); if(jb_>=0)cmask(P0,P1,jb_,qrel,hi);}while(0)
  #define ENDW(tt) do{ if((tt)+3<NT){WAIT_BAR(2);} else if((tt)+2<NT){WAIT_BAR(1);} else {WAIT_BAR(0);} }while(0)
  for(;t+1<NT;t+=2){
    STEP(pB0,pB1,pA0,pA1,t,(t+3<NT),(t+1<NT),(t+1<NT));       ENDW(t);   RESC(); ROT();
    STEP(pA0,pA1,pB0,pB1,t+1,(t+4<NT),(t+2<NT),(t+2<NT));     ENDW(t+1); RESC(); ROT();
  }
  #define DRAIN(P0,P1,slot) do{ float sacc=P0[0]+P0[1]; _Pragma("unroll") for(int r=2;r<16;++r)sacc+=P0[r]; _Pragma("unroll") for(int r=0;r<16;++r)sacc+=P1[r]; l_reg+=sacc; \
    pw0=(u32x4){PKW(P0,0),PKW(P0,2),PKW(P0,4),PKW(P0,6)};pw1=(u32x4){PKW(P0,8),PKW(P0,10),PKW(P0,12),PKW(P0,14)};pw2=(u32x4){PKW(P1,0),PKW(P1,2),PKW(P1,4),PKW(P1,6)};pw3=(u32x4){PKW(P1,8),PKW(P1,10),PKW(P1,12),PKW(P1,14)}; \
    SBAR(); pv(o,vb0+(slot),PAF(0),PAF(1),PAF(2),PAF(3)); }while(0)
  if(wid>=6){ STEP(pB0,pB1,pA0,pA1,NT-1,false,false,false); RESC(); DRAIN(pB0,pB1,sl_cur); }
  else if(wid>=4){ DRAIN(pA0,pA1,sl_prev); }
  #undef DRAIN
  #undef PKW
  #undef PAF
  #undef VFR
  #undef PIN
  #undef MX3
  #undef GAPA
  #undef GAPB
  #undef EX
  #undef VRD
  #undef KRD
  #undef STEP
  #undef ENDW
  {auto rr=__builtin_amdgcn_permlane32_swap(__float_as_uint(l_reg),__float_as_uint(l_reg),false,false);l_reg=__uint_as_float(rr[0])+__uint_as_float(rr[1]);}
  if(hi==0)wsf[32+r32]=l_reg;asm volatile("s_waitcnt lgkmcnt(0)":::"memory");
  float rli[16];
  #pragma unroll
  for(int r=0;r<16;++r)rli[r]=__builtin_amdgcn_rcpf(wsf[32+crow(r,hi)]);
  bf16*Ow=O+(rowbase+q0+wid*QBLK)*DM+h*D; const bf16*Gw=GF+(rowbase+q0+wid*QBLK)*DM+h*D;
  u32x4 gv[4];
  #pragma unroll
  for(int i=0;i<4;++i){const int row=i*8+(lane>>3),ch=lane&7; gv[i]=*(const u32x4*)(Gw+(long)row*DM+ch*8);}
  { bf16*stg=(bf16*)(shm+LDS_OST)+wid*2048;
    #pragma unroll
    for(int r=0;r<16;++r){const int orow=crow(r,hi);
      #pragma unroll
      for(int d0=0;d0<2;++d0)stg[orow*64+d0*32+r32]=__float2bfloat16(o[d0][r]*rli[r]);}
    asm volatile("s_waitcnt lgkmcnt(0)":::"memory");
    #pragma unroll
    for(int i=0;i<4;++i){const int row=i*8+(lane>>3),ch=lane&7; u32x4 v=*(const u32x4*)(stg+row*64+ch*8);
      #pragma unroll
      for(int j=0;j<4;++j){const unsigned a=v[j],g=gv[i][j]; v[j]=cvtpk_s(__uint_as_float(a<<16)*__uint_as_float(g<<16),__uint_as_float(a&0xffff0000u)*__uint_as_float(g&0xffff0000u));}
      ATTN_STORE16(Ow+(long)row*DM+ch*8,v);} }
  asm volatile("s_waitcnt lgkmcnt(0)\n\ts_barrier":::"memory");
  #undef DMA_K
  #undef KAUG
  #undef QAUG
  #undef SETQ
  #undef DMA_V
  #undef CMASK
  #undef START
  #undef RESC
  #undef ROT
}
constexpr int ATTN_LDS_BYTES=LDS_BYTES;
struct AttnTensors { const bf16* Q; const bf16* K; const bf16* V; bf16* O; const bf16* GF; };
#undef SBAR
#undef WAIT_BAR
}
constexpr int NWAVES = 8;
constexpr int BATCH = 16, SEQ = 2048, DMODEL = 1024, NH = 16, HD = 64, CK = 31;
constexpr int M = BATCH * SEQ;
constexpr int IN_COLS = 7184;
constexpr int O_Q = 0, O_K = 1024, O_V = 2048, O_F = 3072, O_GF = 3088, O_GLU = 4112, O_GC = 6160;
constexpr int N1 = 28 * 256;
constexpr int K2 = 2048;
constexpr size_t MiB = 1u << 20;
constexpr int CW_CONV = 3520;
constexpr size_t WS_CTL = 0, CTL_ZERO_BYTES = 16384;
constexpr size_t WS_BT1 = 2 * MiB;
constexpr size_t WS_BT2 = 18 * MiB;
constexpr size_t WS_RS = 26 * MiB;
constexpr size_t WS_LF = 24 * MiB;
constexpr size_t WS_XN = 32 * MiB;
constexpr size_t WS_Q = 96 * MiB, WS_K = 160 * MiB, WS_V = 224 * MiB, WS_GF = 288 * MiB, WS_U = 352 * MiB, WS_GC = 416 * MiB, WS_END = 480 * MiB;
constexpr int RING_BYTES = 131072;
constexpr int LDS_BYTES = 151552;
constexpr int BT_OFF = 98304, BT_BYTES = 32768, WT_OFF = BT_OFF + BT_BYTES;
constexpr int MISC_OFF = WT_OFF + 128;
constexpr int ESTG_OFF = WT_OFF + 512, ESTG_BYTES = 8 * 2304;
static_assert(ESTG_OFF + ESTG_BYTES <= LDS_BYTES, "LDS map");
static_assert(attn_body::ATTN_LDS_BYTES <= BT_OFF && MISC_OFF + 64 <= LDS_BYTES, "LDS map");

#define GAS __attribute__((address_space(1)))
#define LAS __attribute__((address_space(3)))
typedef unsigned short bf16;
typedef unsigned v4u __attribute__((ext_vector_type(4)));
typedef unsigned v2u __attribute__((ext_vector_type(2)));
typedef float f32x4 __attribute__((ext_vector_type(4)));
typedef float f32x2 __attribute__((ext_vector_type(2)));
__device__ __forceinline__ unsigned f2bf(float f) { unsigned u = __builtin_bit_cast(unsigned, f); return (u + 0x7fffu + ((u >> 16) & 1u)) >> 16; }
__device__ __forceinline__ unsigned pk2(float lo, float hi) { return f2bf(lo) | (f2bf(hi) << 16); }
__device__ __forceinline__ float bf_lo(unsigned w) { return __uint_as_float(w << 16); }
__device__ __forceinline__ float bf_hi(unsigned w) { return __uint_as_float(w & 0xffff0000u); }
__device__ __forceinline__ float wave_sum(float v) {
#pragma unroll
    for (int o = 1; o < 64; o <<= 1) v += __shfl_xor(v, o);
    return v;
}
struct Args { const float* in[11]; float* out; unsigned char* ws; int ph_lo, ph_hi; };
typedef const __attribute__((address_space(4))) Args* KArgs;

#define RLX_AGENT __ATOMIC_RELAXED, __HIP_MEMORY_SCOPE_AGENT
#define LDS_WAIT() asm volatile("s_waitcnt lgkmcnt(0)" ::: "memory")
#define VM_WAIT() asm volatile("s_waitcnt vmcnt(0)" ::: "memory")
#define XB_TMO      128
#define XB_XCNT(j)  (256  + 64 * (j))
#define XB_XSUB(j)  (1280 + 64 * (j))
#define XB_XGEN(j)  (2304 + 64 * (j))
#define XB_TOP      3328
#define XB_TOPGEN   3392
#define XCD_BAR_WORDS 3456
#define XB_SPIN_CAP (1u << 18)

__device__ __forceinline__ unsigned xb_ld(unsigned* p)              { return __hip_atomic_load(p, __ATOMIC_RELAXED, __HIP_MEMORY_SCOPE_AGENT); }
__device__ __forceinline__ unsigned xb_add(unsigned* p, unsigned v) { return __hip_atomic_fetch_add(p, v, __ATOMIC_RELAXED, __HIP_MEMORY_SCOPE_AGENT); }
__device__ __forceinline__ unsigned xb_xcc_id() { return (unsigned)__builtin_amdgcn_s_getreg((3 << 11) | 20) & 0xFu; }
#define XB_SPIN(cond, bar) do { unsigned _sp = 0; while (cond) { __builtin_amdgcn_s_sleep(1); \
    if ((++_sp & 255u) == 0u) { if (xb_ld(&(bar)[XB_TMO])) break; if (_sp > XB_SPIN_CAP) { atomicAdd(&(bar)[XB_TMO], 1u); break; } } } } while (0)

struct XcdBarrier {
    unsigned* bar; unsigned x;
    volatile LAS unsigned* st;
};

__device__ __forceinline__ XcdBarrier xcd_barrier_post(unsigned* bar, volatile LAS unsigned* st) {
    XcdBarrier b; b.bar = bar; b.x = xb_xcc_id(); b.st = st;
    if (threadIdx.x == 0) (void)xb_add(&bar[XB_XCNT(b.x)], 1u);
    return b;
}
__device__ __forceinline__ void xcd_barrier_complete(unsigned* bar, unsigned x, unsigned& nloc, unsigned& nx) {
    const unsigned G = gridDim.x * gridDim.y * gridDim.z;
    unsigned sum, cnt, mine, sp = 0u;
    for (;;) {
        sum = 0u; cnt = 0u; mine = 0u;
#pragma unroll
        for (unsigned j = 0; j < 16; ++j) { const unsigned c = xb_ld(&bar[XB_XCNT(j)]); sum += c; cnt += (c > 0u) ? 1u : 0u; mine = (j == x) ? c : mine; }
        if (sum == G) break;
        __builtin_amdgcn_s_sleep(1);
        if ((++sp & 255u) == 0u) { if (xb_ld(&bar[XB_TMO])) break; if (sp > XB_SPIN_CAP) { atomicAdd(&bar[XB_TMO], 1u); break; } }
    }
    nloc = mine > 0u ? mine : 1u; nx = cnt > 0u ? cnt : 1u;
}

__device__ __forceinline__ void xcd_barrier(const XcdBarrier& b) {
    asm volatile("s_waitcnt vmcnt(0)" ::: "memory");
    __syncthreads();
    if (threadIdx.x == 0) {
        unsigned* bar = b.bar;
        __builtin_amdgcn_s_waitcnt(0);
        unsigned nloc = b.st[0], nx = b.st[1];
        if (nloc == 0u) { xcd_barrier_complete(bar, b.x, nloc, nx); b.st[0] = nloc; b.st[1] = nx; }
        const unsigned old = xb_add(&bar[XB_XSUB(b.x)], 1u);
        const unsigned gen = old / nloc;
        if (old + 1u == (gen + 1u) * nloc) {
            __builtin_amdgcn_fence(__ATOMIC_RELEASE, "agent");
            asm volatile("s_waitcnt vmcnt(0)" ::: "memory");
            const unsigned og = xb_add(&bar[XB_TOP], 1u);
            const unsigned tg = og / nx;
            if (og + 1u == (tg + 1u) * nx) xb_add(&bar[XB_TOPGEN], 1u);
            else XB_SPIN(xb_ld(&bar[XB_TOPGEN]) == tg, bar);
            __builtin_amdgcn_fence(__ATOMIC_ACQUIRE, "agent");
            xb_add(&bar[XB_XGEN(b.x)], 1u);
            asm volatile("s_waitcnt vmcnt(0)" ::: "memory");
        } else {
            XB_SPIN(xb_ld(&bar[XB_XGEN(b.x)]) == gen, bar);
            __builtin_amdgcn_fence(__ATOMIC_ACQUIRE, "agent");
            asm volatile("s_waitcnt vmcnt(0)" ::: "memory");
        }
    }
    __syncthreads();
}

__device__ __forceinline__ void p0_transpose_item(const float* __restrict__ W, int ldw, int src_col0, const float* __restrict__ gk, bool use_g, bf16* __restrict__ WT, int K, int dst_row0, int kb, LAS float* scr, int lane) {
    const int k0 = 64 * kb, c = lane & 31, kh = lane >> 5;
    const float* __restrict__ wp = W + (size_t)(k0 + kh) * ldw + src_col0 + c; const float* __restrict__ gp = gk + ((k0 + kh) & (DMODEL - 1));
    float v[32], gg[32];
#pragma unroll
    for (int i = 0; i < 32; ++i) { v[i] = wp[(size_t)(2 * i) * ldw]; gg[i] = gp[2 * i]; }
    asm volatile("" ::: "memory");
#pragma unroll
    for (int i = 0; i < 32; ++i) scr[(2 * i + kh) * 33 + c] = v[i] * (use_g ? gg[i] : 1.0f);
    asm volatile("s_waitcnt lgkmcnt(0)" ::: "memory");
    const int c8 = lane & 7;
#pragma unroll
    for (int j = 0; j < 4; ++j) { const int n = (lane >> 3) + 8 * j; const LAS float* s = scr + (8 * c8) * 33 + n;
        v4u o; o.x = pk2(s[0 * 33], s[1 * 33]); o.y = pk2(s[2 * 33], s[3 * 33]); o.z = pk2(s[4 * 33], s[5 * 33]); o.w = pk2(s[6 * 33], s[7 * 33]);
        *(v4u*)(WT + (size_t)(dst_row0 + n) * K + k0 + 8 * c8) = o; }
    asm volatile("s_waitcnt lgkmcnt(0)" ::: "memory");
}
__device__ __forceinline__ int bt1_src(int rg) {
    const int pn = rg >> 3, tcg = rg & 7, bj = tcg >> 2, wc = tcg & 3;
    if (pn < 4)  return O_Q + 256 * pn + 64 * wc + 32 * bj;
    if (pn < 8)  return O_K + 256 * (pn - 4) + 64 * wc + 32 * bj;
    if (pn < 12) return O_V + 256 * (pn - 8) + 64 * wc + 32 * bj;
    if (pn < 16) return O_GF + 256 * (pn - 12) + 64 * wc + 32 * bj;
    if (pn < 24) return O_GLU + 1024 * bj + 128 * (pn - 16) + 32 * wc;
    return O_GC + 256 * (pn - 24) + 64 * wc + 32 * bj;
}
__device__ __forceinline__ void p0_prologue(KArgs Ap, LAS unsigned char* lds, int vcu, int G, int tid, int wave, int lane) {
    LAS float* scr = (LAS float*)(lds + wave * 16384);
    const int gw = vcu * NWAVES + wave, NGW = G * NWAVES;
    const float* w_in = Ap->in[2]; const float* w_out = Ap->in[10]; const float* ng = Ap->in[1]; unsigned char* ws = Ap->ws;
    bf16* BT1 = (bf16*)(ws + WS_BT1); bf16* BT2 = (bf16*)(ws + WS_BT2);
    constexpr int I1 = (N1 / 32) * 16, I2 = (DMODEL / 32) * (K2 / 64);
    for (int it = gw; it < I1 + I2; it += NGW) {
        if (it < I1) { const int rg = it >> 4, kb = it & 15; p0_transpose_item(w_in, IN_COLS, bt1_src(rg), ng, true, BT1, DMODEL, rg * 32, kb, scr, lane); }
        else { const int r = it - I1, n32 = r >> 5, kb = r & 31; p0_transpose_item(w_out, DMODEL, n32 * 32, ng, false, BT2, K2, n32 * 32, kb, scr, lane); }
    }
    __syncthreads();
    LAS v4u* wf = (LAS v4u*)lds;
    for (int e = tid; e < 32 * 64; e += NWAVES * 64) { const int kk = e >> 6, l = e & 63, kb = 32 * kk + 8 * (l >> 4), hd = l & 15; float v[8];
#pragma unroll
        for (int i = 0; i < 8; ++i) v[i] = w_in[(size_t)(kb + i) * IN_COLS + O_F + hd] * ng[kb + i];
        wf[e] = (v4u){pk2(v[0], v[1]), pk2(v[2], v[3]), pk2(v[4], v[5]), pk2(v[6], v[7])}; }
    __syncthreads();
    const float* x = Ap->in[0]; const float* bfg = Ap->in[3]; bf16* XN = (bf16*)(ws + WS_XN); float* RS = (float*)(ws + WS_RS); float* LF = (float*)(ws + WS_LF);
    const int fr = lane & 15, fq = lane >> 4;
    for (int grp = gw; grp < M / 16; grp += NGW) {
        const int r0 = grp * 16;
        const f32x4* __restrict__ xp = (const f32x4*)(x + (size_t)(r0 + fr) * DMODEL + 8 * fq); v4u* __restrict__ op = (v4u*)(XN + (size_t)(r0 + fr) * DMODEL + 8 * fq);
        pg8::f32x4 acc = {0.f, 0.f, 0.f, 0.f}; float ss = 0.f;
        f32x4 cur[8][2], nxt[8][2];
#pragma unroll
        for (int j = 0; j < 8; ++j) { cur[j][0] = __builtin_nontemporal_load(xp + 8 * j); cur[j][1] = __builtin_nontemporal_load(xp + 8 * j + 1); }
#pragma unroll
        for (int kb8 = 0; kb8 < 32; kb8 += 8) {
            if (kb8 + 8 < 32) {
#pragma unroll
                for (int j = 0; j < 8; ++j) { nxt[j][0] = __builtin_nontemporal_load(xp + 8 * (kb8 + 8 + j)); nxt[j][1] = __builtin_nontemporal_load(xp + 8 * (kb8 + 8 + j) + 1); }
            }
            asm volatile("" ::: "memory");
#pragma unroll
            for (int j = 0; j < 8; ++j) { const int kk = kb8 + j; const f32x4 a0 = cur[j][0], a1 = cur[j][1];
                ss += (a0.x * a0.x + a0.y * a0.y) + (a0.z * a0.z + a0.w * a0.w) + (a1.x * a1.x + a1.y * a1.y) + (a1.z * a1.z + a1.w * a1.w);
                const v4u av = {attn_body::cvtpk_s(a0.x, a0.y), attn_body::cvtpk_s(a0.z, a0.w), attn_body::cvtpk_s(a1.x, a1.y), attn_body::cvtpk_s(a1.z, a1.w)};
                op[4 * kk] = av;
                acc = __builtin_amdgcn_mfma_f32_16x16x32_bf16(__builtin_bit_cast(pg8::bf16x8, av), __builtin_bit_cast(pg8::bf16x8, wf[kk * 64 + lane]), acc, 0, 0, 0); }
            asm volatile("" ::: "memory");
#pragma unroll
            for (int j = 0; j < 8; ++j) { cur[j][0] = nxt[j][0]; cur[j][1] = nxt[j][1]; }
        }
        ss += __shfl_xor(ss, 16); ss += __shfl_xor(ss, 32);
        const float rs = 1.0f / sqrtf(ss * (1.f / DMODEL) + pg8::kEPS);
        if (fq == 0) RS[r0 + fr] = rs;
        const float bb = bfg[fr];
#pragma unroll
        for (int e = 0; e < 4; ++e) { const int r = 4 * fq + e; const float z = __shfl(rs, r) * acc[e] + bb;
            LF[(size_t)(r0 + r) * 16 + fr] = fminf(z, 0.f) - log1pf(expf(-fabsf(z))); }
    }
}

__device__ __forceinline__ f32x2 unpk(unsigned w) { return (f32x2){bf_lo(w), bf_hi(w)}; }
__device__ __forceinline__ void conv_phase(KArgs Ap, LAS unsigned char* lds, int vcu, int G, int tid, int wave, int lane, size_t out_off) {
    (void)vcu; (void)G;
    LAS float* red = (LAS float*)lds;
    LAS f32x2* fin = (LAS f32x2*)(lds + 1024);
    const int c0 = 2 * tid;
    const float* cw = Ap->in[6]; unsigned char* ws = Ap->ws;
    f32x2 w[CK];
#pragma unroll
    for (int j = 0; j < CK; ++j) w[j] = *(const f32x2*)(cw + j * 1024 + c0);
    const f32x2 cb = *(const f32x2*)(Ap->in[7] + c0), lg = *(const f32x2*)(Ap->in[8] + c0), lb = *(const f32x2*)(Ap->in[9] + c0);
    const bf16* U = (const bf16*)(ws + WS_U); bf16* GC = (bf16*)(ws + WS_GC);
    unsigned* ctr = (unsigned*)(ws + WS_CTL) + CW_CONV; volatile LAS int* ubox = (volatile LAS int*)(lds + 2048);
    for (;;) {
        if (tid == 0) ubox[0] = (int)__hip_atomic_fetch_add(ctr, 1u, __ATOMIC_RELAXED, __HIP_MEMORY_SCOPE_AGENT);
        __syncthreads();
        const int unit = ubox[0];
        __syncthreads();
        if (unit >= M / 64) break;
        const int row0 = unit * 64, t0 = row0 & (SEQ - 1);
        const bf16* Up = U + (size_t)row0 * 1024 + c0; bf16* Gp = GC + (size_t)row0 * 1024 + c0; bf16* Op = (bf16*)(ws + out_off) + (size_t)row0 * 1024 + c0;
        f32x2 win[38];
#pragma unroll
        for (int i = 0; i < 30; ++i) { const unsigned raw = (t0 - 30 + i >= 0) ? *(const unsigned*)(Up + (long)(i - 30) * 1024) : 0u; win[i] = unpk(raw); }
        unsigned nx[8], nx2[8], gcn[8];
#pragma unroll
        for (int i = 0; i < 8; ++i) nx[i] = *(const unsigned*)(Up + (long)i * 1024);
#pragma unroll
        for (int i = 0; i < 8; ++i) nx2[i] = *(const unsigned*)(Up + (long)(8 + i) * 1024);
#pragma unroll
        for (int i = 0; i < 8; ++i) gcn[i] = *(const unsigned*)(Gp + (long)i * 1024);
#pragma unroll 1
        for (int ch = 0; ch < 8; ++ch) {
            unsigned gcr[8];
#pragma unroll
            for (int i = 0; i < 8; ++i) { win[30 + i] = unpk(nx[i]); nx[i] = nx2[i]; gcr[i] = gcn[i]; }
            { const int c2 = (ch + 2 < 8) ? ch + 2 : 7, c1 = (ch + 1 < 8) ? ch + 1 : 7;
#pragma unroll
              for (int i = 0; i < 8; ++i) nx2[i] = *(const unsigned*)(Up + (long)(c2 * 8 + i) * 1024);
#pragma unroll
              for (int i = 0; i < 8; ++i) gcn[i] = *(const unsigned*)(Gp + (long)(c1 * 8 + i) * 1024); }
            f32x2 y[8];
#pragma unroll
            for (int i = 0; i < 8; ++i) { f32x2 a = cb;
#pragma unroll
                for (int j = 0; j < CK; ++j) a += w[j] * win[i + j];
                y[i] = a; }
            float st[16];
#pragma unroll
            for (int i = 0; i < 8; ++i) { st[2 * i] = y[i].x + y[i].y; st[2 * i + 1] = y[i].x * y[i].x + y[i].y * y[i].y; }
            {
#pragma unroll
              for (int k = 0; k < 8; ++k) { const auto r = __builtin_amdgcn_permlane32_swap(__float_as_uint(st[k]), __float_as_uint(st[k + 8]), false, false); st[k] = __uint_as_float(r[0]) + __uint_as_float(r[1]); }
#pragma unroll
              for (int k = 0; k < 4; ++k) { const auto r = __builtin_amdgcn_permlane16_swap(__float_as_uint(st[k]), __float_as_uint(st[k + 4]), false, false); st[k] = __uint_as_float(r[0]) + __uint_as_float(r[1]); }
              const bool h3 = (lane & 8) != 0;
#pragma unroll
              for (int k = 0; k < 2; ++k) { const float send = h3 ? st[k] : st[k + 2], keep = h3 ? st[k + 2] : st[k]; st[k] = keep + __shfl_xor(send, 8); }
              const bool h2 = (lane & 4) != 0;
              { const float send = h2 ? st[0] : st[1], keep = h2 ? st[1] : st[0]; st[0] = keep + __shfl_xor(send, 4); }
              st[0] += __shfl_xor(st[0], 2); st[0] += __shfl_xor(st[0], 1); }
            const int pb = ch & 1;
            if ((lane & 3) == 0) red[(pb * 8 + wave) * 16 + ((lane >> 2) & 15)] = st[0];
            __syncthreads();
            if (tid < 8) { float s1 = 0.f, s2 = 0.f;
#pragma unroll
                for (int wv = 0; wv < 8; ++wv) { s1 += red[(pb * 8 + wv) * 16 + 2 * tid]; s2 += red[(pb * 8 + wv) * 16 + 2 * tid + 1]; }
                const float mu = s1 * (1.f / 1024.f), var = fmaxf(s2 * (1.f / 1024.f) - mu * mu, 0.f);
                fin[pb * 8 + tid] = (f32x2){mu, 1.0f / sqrtf(var + pg8::kEPS)}; }
            __syncthreads();
#pragma unroll
            for (int i = 0; i < 8; ++i) { const f32x2 ms = fin[pb * 8 + i]; const f32x2 a = lg * ms.y, b = lb - a * ms.x; const f32x2 z = y[i] * a + b; const f32x2 gg = unpk(gcr[i]);
                const f32x2 t = z * (-pg8::kLOG2E); f32x2 d; d.x = __builtin_amdgcn_exp2f(t.x); d.y = __builtin_amdgcn_exp2f(t.y); d = d + 1.0f;
                f32x2 r; r.x = __builtin_amdgcn_rcpf(d.x); r.y = __builtin_amdgcn_rcpf(d.y);
                const f32x2 o = (z * r) * gg;
                *(unsigned*)(Op + (long)(ch * 8 + i) * 1024) = pg8::cvt_pk_bf16(o.x, o.y); }
#pragma unroll
            for (int i = 0; i < 30; ++i) asm("v_pk_mov_b32 %0, %1, %1 op_sel:[0,1]" : "=v"(win[i]) : "v"(win[i + 8]));
        }
    }
    __syncthreads();
}

__device__ __forceinline__ void build_bias_table(const float* LF, const float* gq, const float* gk, int bh, LAS unsigned char* lds, int tid, int wave, int lane) {
    LAS v4u* tab = (LAS v4u*)(lds + BT_OFF); LAS float* wtot = (LAS float*)(lds + WT_OFF); LAS float* te = (LAS float*)(lds + WT_OFF + 256);
    const int b = bh >> 4, h = bh & 15;
    const float* lf = LF + (size_t)b * SEQ * 16 + h;
    const int t0 = 4 * tid; float v[4];
#pragma unroll
    for (int i = 0; i < 4; ++i) v[i] = lf[(size_t)(t0 + i) * 16];
    v[1] += v[0]; v[2] += v[1]; v[3] += v[2];
    const float tot = v[3]; float inc = tot;
#pragma unroll
    for (int o = 1; o < 64; o <<= 1) { const float n = __shfl_up(inc, o); if (lane >= o) inc += n; }
    if (lane == 63) wtot[wave] = inc;
    __syncthreads();
    float off = inc - tot;
    for (int wv = 0; wv < wave; ++wv) off += wtot[wv];
#pragma unroll
    for (int i = 0; i < 4; ++i) { const float bias = -(v[i] + off) * pg8::kLOG2E;
        const unsigned b1 = f2bf(bias); const float r1 = bias - __uint_as_float(b1 << 16);
        const unsigned b2 = f2bf(r1);   const float r2 = r1 - __uint_as_float(b2 << 16);
        const unsigned b3 = f2bf(r2);
        tab[t0 + i] = (v4u){b1 | (b2 << 16), b3 | 0x3F800000u, 0x3F803F80u, 0u};
        if (i == 3 && (tid & 15) == 15) te[tid >> 4] = bias; }
    if (wave == 0) { float mq = fabsf(gq[h * 64 + lane]), mk = fabsf(gk[h * 64 + lane]);
#pragma unroll
        for (int o = 1; o < 64; o <<= 1) { mq = fmaxf(mq, __shfl_xor(mq, o)); mk = fmaxf(mk, __shfl_xor(mk, o)); }
        if (lane == 0) te[32] = 2.0f * (8.0f * pg8::kLOG2E * 1.03f * mq * mk) + 75.0f; }
    __syncthreads();
}
__global__ void __launch_bounds__(NWAVES * 64, 2) skel_fwd(Args args) {
    extern __shared__ __attribute__((aligned(16))) unsigned char lds_raw[];
    LAS unsigned char* lds = (LAS unsigned char*)lds_raw;
    const int G = gridDim.x, bx = blockIdx.x, vcu = (G % 8 == 0) ? (bx % 8) * (G / 8) + bx / 8 : bx;
#define PHASE_IDS() int tid = threadIdx.x; asm volatile("" : "+v"(tid)); const int lane = tid & 63, wave = __builtin_amdgcn_readfirstlane(tid >> 6); (void)lane; (void)wave
#define KARGS() ({ KArgs k_ = (KArgs)__builtin_amdgcn_kernarg_segment_ptr(); asm volatile("" : "+s"(k_)); k_; })
#if MK_N_LAUNCHES == 1
#define IN(k) true
#define GRID_BAR() xcd_barrier(bar)
#else
    const int lo = args.ph_lo, hi = args.ph_hi;
#define IN(k) (lo <= (k) && (k) < hi)
#define GRID_BAR() do {} while (0)
#endif

#if MK_N_LAUNCHES == 1
    if (threadIdx.x < 2) ((volatile LAS unsigned*)(lds + MISC_OFF))[threadIdx.x] = 0u;
    __syncthreads();
    XcdBarrier bar = xcd_barrier_post((unsigned*)(KARGS()->ws + WS_CTL), (volatile LAS unsigned*)(lds + MISC_OFF));
    if (KARGS()->ph_lo < 0) cg::this_grid().sync();
#endif
    if (IN(0)) { PHASE_IDS(); int nrep0 = (MK_PROBE == 1) ? 2 : 1; asm volatile("" : "+s"(nrep0));
#pragma unroll 1
        for (int r = 0; r < nrep0; ++r) { p0_prologue(KARGS(), lds, vcu, G, tid, wave, lane); __syncthreads(); }

 if (IN(1)) GRID_BAR(); }

    if (IN(1)) {
        KArgs Ap = KARGS(); unsigned char* ws = Ap->ws;
        pg8::Gemm g{(const bf16*)(ws + WS_XN), (const bf16*)(ws + WS_BT1), M, N1, DMODEL, DMODEL, 1 << 30, 0l}; pg8::StaticOrder S; S.init(M, N1, G, bx);
        pg8::Epi1 E{(bf16*)(ws + WS_Q), (const float*)(ws + WS_RS), Ap->in[4], Ap->in[5], lds + ESTG_OFF};
        int nrep1 = (MK_PROBE == 2) ? 2 : 1; asm volatile("" : "+s"(nrep1));
#pragma unroll 1
        for (int r = 0; r < nrep1; ++r) { pg8::gemm_phase<pg8::Epi1, pg8::StaticOrder, true, true>(lds, g, S, E); __syncthreads(); }
#if MK_N_LAUNCHES == 1
        { PHASE_IDS(); build_bias_table((const float*)(ws + WS_LF), Ap->in[4], Ap->in[5], (G == BATCH * NH) ? (vcu & ~15) + ((vcu & 15) >> 1) : vcu % (BATCH * NH), lds, tid, wave, lane); }
#endif
        if (IN(2)) GRID_BAR();
    }

    if (IN(2)) {
        { PHASE_IDS();
        unsigned char* ws = KARGS()->ws;
        const attn_body::bf16* QB = (const attn_body::bf16*)(ws + WS_Q);
        int cur_bh = (MK_N_LAUNCHES == 1) ? ((G == BATCH * NH) ? (vcu & ~15) + ((vcu & 15) >> 1) : vcu % (BATCH * NH)) : -1;
        int pass0 = (MK_PROBE == 4) ? 0 : 1; asm volatile("" : "+s"(pass0));
#pragma unroll 1
        for (int pass = pass0; pass < 2; ++pass)
        for (int ui = 0; (G == BATCH * NH) ? ui < SEQ / 256 : vcu + ui * G < BATCH * NH * (SEQ / 256); ++ui) {
            int bh, qb;
            if (G == BATCH * NH) { const int j = (vcu & 15) >> 1, sx = vcu & 1, grp = ui >> 2, set = grp ? 1 - sx : sx, k4 = 4 * (ui & 3);
                qb = ((set ? 0x6521 : 0x7430) >> k4) & 15; bh = (vcu & ~15) + (grp ? 15 - j : j); }
            else { const int L = vcu + ui * G; bh = L % (BATCH * NH); qb = L / (BATCH * NH); }
            if (bh != cur_bh) { KArgs Aq = KARGS(); build_bias_table((const float*)(ws + WS_LF), Aq->in[4], Aq->in[5], bh, lds, tid, wave, lane); cur_bh = bh; }
            int ts = 0;
            if (qb > 0) { const LAS float* te = (const LAS float*)(lds + WT_OFF + 256); const float ref = te[4 * qb - 1], th = te[32];
                const bool c = lane < 32 && lane < 4 * qb && (ref - te[lane & 31] > th); ts = (int)__popcll(__ballot(c)) & ~1; }
            ts = __builtin_amdgcn_readfirstlane(ts);
#ifndef NO_ATTN
            attn_body::attn_unit<96>(bh >> 4, bh & 15, qb, ts, QB, QB + pg8::Epi1::ZS, QB + 2 * pg8::Epi1::ZS, pass ? (attn_body::bf16*)QB : (attn_body::bf16*)(ws + WS_XN), QB + 3 * pg8::Epi1::ZS, (char*)lds_raw, (attn_body::lds_cptr)(lds + BT_OFF));
#endif
        }
        }
        __syncthreads();
#ifndef NO_CONV
        { PHASE_IDS(); conv_phase(KARGS(), lds, vcu, G, tid, wave, lane, WS_GC); }
#endif
        if (IN(3)) GRID_BAR();
    }

    if (IN(3)) {
        KArgs Ap = KARGS(); unsigned char* ws = Ap->ws;
        pg8::Gemm g{(const bf16*)(ws + WS_Q), (const bf16*)(ws + WS_BT2), M, DMODEL, K2, DMODEL, 16, (long)(WS_GC - WS_Q) - 16l * 128l}; pg8::StaticOrder S; S.init(M, DMODEL, G, bx);
        pg8::Epi2 E{Ap->in[0], Ap->out, lds + ESTG_OFF};
        int nrep3 = (MK_PROBE == 5) ? 2 : 1; asm volatile("" : "+s"(nrep3));
#pragma unroll 1
        for (int r = 0; r < nrep3; ++r) { pg8::gemm_phase<pg8::Epi2, pg8::StaticOrder, true, true>(lds, g, S, E); __syncthreads(); }
    }
#undef KARGS
#undef IN
}

extern "C" void kernel_launch(void* const* d_in, const int* in_sizes, int n_in, void* d_out, int out_size, void* d_ws, size_t ws_size, hipStream_t stream) {
    static int grid = 0;
    if (grid == 0) {
        if (n_in != 11 || in_sizes[0] != M * DMODEL || out_size != M * DMODEL || ws_size < WS_END) { fprintf(stderr, "kernel_launch: shape/workspace mismatch (n_in %d, in0 %d, out %d, ws %zu)\n", n_in, n_in > 0 ? in_sizes[0] : -1, out_size, ws_size); grid = -1; return; }
        int dev = 0, cus = 0, per_cu = 0;
        if (hipGetDevice(&dev) != hipSuccess || hipDeviceGetAttribute(&cus, hipDeviceAttributeMultiprocessorCount, dev) != hipSuccess) { grid = -1; return; }
        if (hipFuncSetAttribute((const void*)skel_fwd, hipFuncAttributeMaxDynamicSharedMemorySize, LDS_BYTES) != hipSuccess) { fprintf(stderr, "kernel_launch: hipFuncSetAttribute failed\n"); grid = -1; return; }
        if (hipOccupancyMaxActiveBlocksPerMultiprocessor(&per_cu, (const void*)skel_fwd, NWAVES * 64, LDS_BYTES) != hipSuccess || per_cu < 1) { fprintf(stderr, "kernel_launch: occupancy query says %d blocks per CU\n", per_cu); per_cu = 1; }
        (void)hipGetLastError();
        grid = cus;
    }
    if (grid < 0) return;
    if (hipMemsetAsync((char*)d_ws + WS_CTL, 0, CTL_ZERO_BYTES, stream) != hipSuccess) { fprintf(stderr, "kernel_launch: hipMemsetAsync failed\n"); return; }
    Args a{};
    for (int i = 0; i < 11; ++i) a.in[i] = (const float*)d_in[i];
    a.out = (float*)d_out; a.ws = (unsigned char*)d_ws;
#if MK_N_LAUNCHES == 1
    a.ph_lo = 0; a.ph_hi = 4;
    void* kargs[] = {&a};
    hipError_t e = hipLaunchCooperativeKernel((const void*)skel_fwd, dim3(grid), dim3(NWAVES * 64), kargs, LDS_BYTES, stream);
    if (e != hipSuccess) fprintf(stderr, "cooperative launch failed: %s (grid %d)\n", hipGetErrorString(e), grid);
#else
    for (int p = 0; p < 4; ++p) { a.ph_lo = p; a.ph_hi = p + 1; hipLaunchKernelGGL(skel_fwd, dim3(grid), dim3(NWAVES * 64), LDS_BYTES, stream, a); }
#endif
}
```

```cpp
#include <hip/hip_runtime.h>
#include <hip/hip_cooperative_groups.h>
#include <cstdio>
#include <cstdint>
namespace cg = cooperative_groups;
#ifndef MK_PROBE
#define MK_PROBE 0
#endif
#ifndef MK_N_LAUNCHES
#define MK_N_LAUNCHES 1
#endif
namespace pg8 {
#define PG8_LAS __attribute__((address_space(3)))
typedef unsigned short bf16_t;
typedef short bf16x8 __attribute__((ext_vector_type(8)));
typedef float f32x4 __attribute__((ext_vector_type(4)));
typedef unsigned u32x4 __attribute__((ext_vector_type(4)));
constexpr int BM = 256, BK = 64, HALF = 128, HTB = HALF * BK * 2  , STAGE_BYTES = 8 * HTB, NXCD = 8, WGM = 2;

__host__ __device__ __forceinline__ int lds_byte(int r, int c) { const int st = (r >> 4) * 2 + (c >> 5), rr = r & 15, cc = c & 31, ob = rr * 64 + cc * 2; return st * 1024 + (ob ^ (((ob >> 9) & 1) << 5)); }
__host__ __device__ __forceinline__ void stage_rc(int b, int& R, int& C) { const int st = b / 1024, sb = b % 1024, swz = sb ^ (((sb >> 9) & 1) << 5); R = (st >> 1) * 16 + swz / 64; C = (st & 1) * 32 + (swz % 64) / 2; }
__host__ __device__ __forceinline__ int perm32(int rho) { const int n = rho >> 4, i = rho & 15; return 8 * (i >> 2) + 4 * n + (i & 3); }

struct Unit { int pm, pn; };
struct Gemm { const bf16_t* A; const bf16_t* Bt; int M, N, K; int lda; int ksplit; long ajump; };

struct StaticOrder {
    int nM, nN, nwg, G, c;
    __host__ __device__ void init(int M, int N, int G_, int c_) { nM = M / BM; nN = N / BM; nwg = nM * nN; G = G_; c = c_; }
    __host__ __device__ bool next(int i, Unit& u) const {
        const long L = (long)i * G + c; if (L >= nwg) return false;
        int wgid = (int)L; { const int q = nwg / NXCD, r = nwg % NXCD, xcd = wgid % NXCD, off = wgid / NXCD; wgid = (xcd < r ? xcd * (q + 1) : r * (q + 1) + (xcd - r) * q) + off; }
        const int nig = WGM * nN, gid = wgid / nig, fm = gid * WGM, gsz = (nM - fm) < WGM ? (nM - fm) : WGM;
        u.pm = fm + ((wgid % nig) % gsz); u.pn = (wgid % nig) / gsz; return true;
    }
    __device__ __forceinline__ void a_ready(const Unit&) const {}
    __device__ __forceinline__ void done(const Unit&) const {}
};
typedef __bf16 bf16x2v __attribute__((ext_vector_type(2)));
typedef float f32x2 __attribute__((ext_vector_type(2)));
__device__ __forceinline__ unsigned cvt_pk_bf16(float lo, float hi) { const f32x2 v = {lo, hi}; return __builtin_bit_cast(unsigned, __builtin_convertvector(v, bf16x2v)); }
constexpr float kEPS = 1e-6f, kLOG2E = 1.4426950408889634f, kC2 = 0.125f * 1.4426950408889634f;
__device__ __forceinline__ float sigmoid_f(float x) { return __builtin_amdgcn_rcpf(1.0f + __builtin_amdgcn_exp2f(-kLOG2E * x)); }
__device__ __forceinline__ f32x4 sigmoid4(f32x4 x) { const f32x4 t = x * (-kLOG2E); f32x4 e; e[0] = __builtin_amdgcn_exp2f(t[0]); e[1] = __builtin_amdgcn_exp2f(t[1]); e[2] = __builtin_amdgcn_exp2f(t[2]); e[3] = __builtin_amdgcn_exp2f(t[3]);
    e = e + 1.0f; f32x4 r; r[0] = __builtin_amdgcn_rcpf(e[0]); r[1] = __builtin_amdgcn_rcpf(e[1]); r[2] = __builtin_amdgcn_rcpf(e[2]); r[3] = __builtin_amdgcn_rcpf(e[3]); return r; }
__device__ __forceinline__ u32x4 pack8(f32x4 v0, f32x4 v1) { u32x4 w; w.x = cvt_pk_bf16(v0[0], v0[1]); w.y = cvt_pk_bf16(v0[2], v0[3]); w.z = cvt_pk_bf16(v1[0], v1[1]); w.w = cvt_pk_bf16(v1[2], v1[3]); return w; }
struct Epi1 {
    static constexpr bool PERM = true, AFTER_DRAIN = false;
    bf16_t* Z; const float* RS; const float *qg, *kg; PG8_LAS unsigned char* stg;
    static constexpr size_t ZS = (size_t)32 << 20;
    __device__ __forceinline__ void operator()(const f32x4 (&acc)[2][2][4][2], const Unit& u, int wr, int wc, int fr, int fq) const {
        const int pn = u.pn; const int row0 = u.pm * BM + wr * 64 + fr;
        float rsv[2][4];
#pragma unroll
        for (int ai = 0; ai < 2; ++ai)
#pragma unroll
            for (int m = 0; m < 4; ++m) rsv[ai][m] = RS[row0 + ai * HALF + m * 16];
        const int l_ = fr + 16 * fq, rr_ = l_ >> 3, cc_ = l_ & 7;
        PG8_LAS unsigned char* slab = stg + (wr * 4 + wc) * 2304;
        PG8_LAS u32x4* wp = (PG8_LAS u32x4*)(slab + fr * 144 + fq * 16); const PG8_LAS u32x4* rp = (const PG8_LAS u32x4*)(slab + rr_ * 144 + cc_ * 16);
        const size_t rowst = (size_t)(u.pm * BM + wr * 64 + rr_) * 1024;
#define EPI1_STORE128(basep, colw, AI, MM, W0, W1) do { wp[0] = (W0); wp[4] = (W1); asm volatile("s_waitcnt lgkmcnt(0)" ::: "memory"); const u32x4 a_ = rp[0], b_ = rp[72]; asm volatile("s_waitcnt lgkmcnt(0)" ::: "memory"); \
            bf16_t* d_ = (basep) + rowst + (size_t)((AI) * HALF + (MM) * 16) * 1024 + (colw) + 8 * cc_; *(u32x4*)d_ = a_; *(u32x4*)(d_ + 8 * 1024) = b_; } while (0)
        if (pn < 8) {
            const bool isq = pn < 4; const int sec = isq ? pn : pn - 4;
            bf16_t* base = Z + (isq ? 0 : ZS); const float* gp = (isq ? qg : kg) + (sec * 4 + wc) * 64 + 8 * fq; const float sc = isq ? kC2 : 1.0f;
            f32x4 g[2][2];
#pragma unroll
            for (int bj = 0; bj < 2; ++bj)
#pragma unroll
                for (int n = 0; n < 2; ++n) g[bj][n] = *(const f32x4*)(gp + 32 * bj + 4 * n) * sc;
#pragma unroll
            for (int ai = 0; ai < 2; ++ai)
#pragma unroll
                for (int m = 0; m < 4; ++m) {
                    float ss = 0.f;
#pragma unroll
                    for (int bj = 0; bj < 2; ++bj)
#pragma unroll
                        for (int n = 0; n < 2; ++n) { const f32x4 x = acc[ai][bj][m][n]; ss += (x[0] * x[0] + x[1] * x[1]) + (x[2] * x[2] + x[3] * x[3]); }
                    ss += __shfl_xor(ss, 16); ss += __shfl_xor(ss, 32);
                    const float rs = rsv[ai][m];
                    const float rinv = rs * __builtin_amdgcn_rsqf(ss * rs * rs * (1.0f / 64.0f) + kEPS);
                    const u32x4 w0 = pack8(acc[ai][0][m][0] * rinv * g[0][0], acc[ai][0][m][1] * rinv * g[0][1]), w1 = pack8(acc[ai][1][m][0] * rinv * g[1][0], acc[ai][1][m][1] * rinv * g[1][1]);
                    EPI1_STORE128(base, sec * 256 + wc * 64, ai, m, w0, w1);
                }
        } else if (pn < 16 || pn >= 24) {
            const bool act = pn >= 12; const int sec = pn < 12 ? pn - 8 : (pn < 16 ? pn - 12 : pn - 24);
            bf16_t* base = Z + (size_t)(pn < 12 ? 2 : (pn < 16 ? 3 : 5)) * ZS;
#pragma unroll
            for (int ai = 0; ai < 2; ++ai)
#pragma unroll
                for (int m = 0; m < 4; ++m) { const float rs = rsv[ai][m]; u32x4 w[2];
#pragma unroll
                    for (int bj = 0; bj < 2; ++bj) { f32x4 v0 = acc[ai][bj][m][0] * rs, v1 = acc[ai][bj][m][1] * rs;
                        if (act) { v0 = v0 * sigmoid4(v0); v1 = v1 * sigmoid4(v1); }
                        w[bj] = pack8(v0, v1); }
                    EPI1_STORE128(base, sec * 256 + wc * 64, ai, m, w[0], w[1]); }
        } else {
            const int r4 = l_ >> 2, c4 = l_ & 3; const PG8_LAS u32x4* rp4 = (const PG8_LAS u32x4*)(slab + r4 * 144 + c4 * 16);
            bf16_t* ub = Z + 4 * ZS + (size_t)(u.pm * BM + wr * 64 + r4) * 1024 + (pn - 16) * 128 + wc * 32 + 8 * c4;
#pragma unroll
            for (int ai = 0; ai < 2; ++ai)
#pragma unroll
                for (int m = 0; m < 4; ++m) { const float rs = rsv[ai][m]; f32x4 v0 = acc[ai][0][m][0] * rs, v1 = acc[ai][0][m][1] * rs; const f32x4 g0 = acc[ai][1][m][0] * rs, g1 = acc[ai][1][m][1] * rs;
                    v0 = v0 * sigmoid4(g0); v1 = v1 * sigmoid4(g1);
                    wp[0] = pack8(v0, v1); asm volatile("s_waitcnt lgkmcnt(0)" ::: "memory"); const u32x4 a_ = rp4[0]; asm volatile("s_waitcnt lgkmcnt(0)" ::: "memory");
                    *(u32x4*)(ub + (size_t)(ai * HALF + m * 16) * 1024) = a_; }
        }
#undef EPI1_STORE128
    }
};
struct Epi2 {
    static constexpr bool PERM = true, AFTER_DRAIN = false;
    const float* __restrict__ x; float* __restrict__ out; PG8_LAS unsigned char* stg;
    __device__ __forceinline__ void operator()(const f32x4 (&acc)[2][2][4][2], const Unit& u, int wr, int wc, int fr, int fq) const {
        const int l = fr + 16 * fq, rr = l >> 3, cc = l & 7;
        PG8_LAS unsigned char* slab = stg + (wr * 4 + wc) * 2304;
        PG8_LAS f32x4* wp = (PG8_LAS f32x4*)(slab + fr * 144 + fq * 32); const PG8_LAS f32x4* rp = (const PG8_LAS f32x4*)(slab + rr * 144 + cc * 16);
        const size_t g0 = (size_t)(u.pm * BM + wr * 64 + rr) * 1024 + u.pn * BM + wc * 32 + 4 * cc;
        const float* __restrict__ xb = x + g0; float* __restrict__ ob = out + g0;
#pragma unroll
        for (int ai = 0; ai < 2; ++ai) {
            f32x4 pre[4][2][2];
#pragma unroll
            for (int m = 0; m < 4; ++m)
#pragma unroll
                for (int bj = 0; bj < 2; ++bj)
#pragma unroll
                    for (int r = 0; r < 2; ++r) pre[m][bj][r] = *(const f32x4*)(xb + (size_t)(ai * HALF + m * 16 + 8 * r) * 1024 + bj * HALF);
            asm volatile("" ::: "memory");
#pragma unroll
            for (int m = 0; m < 4; ++m)
#pragma unroll
                for (int bj = 0; bj < 2; ++bj) {
                    wp[0] = acc[ai][bj][m][0]; wp[1] = acc[ai][bj][m][1];
                    asm volatile("s_waitcnt lgkmcnt(0)" ::: "memory");
                    const f32x4 v0 = rp[0], v1 = rp[8 * 9];
                    asm volatile("s_waitcnt lgkmcnt(0)" ::: "memory");
                    *(f32x4*)(ob + (size_t)(ai * HALF + m * 16) * 1024 + bj * HALF) = pre[m][bj][0] + v0;
                    *(f32x4*)(ob + (size_t)(ai * HALF + m * 16 + 8) * 1024 + bj * HALF) = pre[m][bj][1] + v1;
                }
            asm volatile("" ::: "memory");
        }
    }
};
template <class Epi, class Sched, bool ALIGN_EPI = false, bool SP2 = false>
__device__ __forceinline__ void gemm_phase(PG8_LAS unsigned char* lds, const Gemm g, const Sched& S, const Epi& E) {
    int tid_ = threadIdx.x; asm volatile("" : "+v"(tid_));
    const int tid = tid_, wid = __builtin_amdgcn_readfirstlane(tid >> 6), lane = tid & 63, wr = wid >> 2, wc = wid & 3, fr = lane & 15, fq = lane >> 4;
    const int K = g.K, nt = K / BK;
    unsigned voffA[2], voffB[2];
#pragma unroll
    for (int i = 0; i < 2; ++i) { int R, C; stage_rc(tid * 16 + i * 8192, R, C); const int Rb = Epi::PERM ? ((R & ~31) + perm32(R & 31)) : R;
        voffA[i] = (unsigned)(R * g.lda + C) * 2u; voffB[i] = (unsigned)(Rb * K + C) * 2u; }
    const size_t kstep = (size_t)(BK * 2);
    const size_t hstepA = (size_t)HALF * g.lda * 2, hstepB = (size_t)HALF * K * 2;
    const size_t tstepA = 2 * hstepA, tstepB = 2 * hstepB;
    const int ksplit = g.ksplit; const long ajump = g.ajump;
#define PG8_KOFF(t) ((size_t)(t) * kstep + ((t) >= ksplit ? ajump : 0l))
    const unsigned ldsw = (unsigned)wid * 1024u;
    const int aoff = lds_byte(wr * 64 + fr, fq * 8), boff = lds_byte(wc * 32 + fr, fq * 8);
#define PG8_SA(b, h) (((b) * 2 + (h)) * HTB)
#define PG8_SB(b, h) ((4 + (b) * 2 + (h)) * HTB)
#define PG8_STAGE(bufoff, gbase, voff) do { _Pragma("unroll") for (int _i = 0; _i < 2; ++_i) \
        __builtin_amdgcn_global_load_lds((const unsigned*)((const char*)(gbase) + (voff)[_i]), (PG8_LAS unsigned*)(lds + (bufoff) + ldsw + _i * 8192), 16, 0, 0); } while (0)
#define PG8_LDA(dst, b, h) do { _Pragma("unroll") for (int m = 0; m < 4; ++m) _Pragma("unroll") for (int k = 0; k < 2; ++k) dst[m][k] = *(const PG8_LAS bf16x8*)(lds + PG8_SA(b, h) + aoff + m * 2048 + k * 1024); } while (0)
#define PG8_LDB(dst, b, h) do { _Pragma("unroll") for (int n = 0; n < 2; ++n) _Pragma("unroll") for (int k = 0; k < 2; ++k) dst[n][k] = *(const PG8_LAS bf16x8*)(lds + PG8_SB(b, h) + boff + n * 2048 + k * 1024); } while (0)
#define PG8_MMA(ai, bj, At, Bt) do { __builtin_amdgcn_s_setprio(1); _Pragma("unroll") for (int m = 0; m < 4; ++m) _Pragma("unroll") for (int n = 0; n < 2; ++n) _Pragma("unroll") for (int k = 0; k < 2; ++k) \
        acc[ai][bj][m][n] = __builtin_amdgcn_mfma_f32_16x16x32_bf16(Bt[n][k], At[m][k], acc[ai][bj][m][n], 0, 0, 0); __builtin_amdgcn_s_setprio(0); } while (0)
#define PG8_WAIT_V(n) asm volatile("s_waitcnt vmcnt(" #n ")" ::: "memory")
#define PG8_WAIT_L(n) asm volatile("s_waitcnt lgkmcnt(" #n ")" ::: "memory")
#define PG8_BAR __builtin_amdgcn_s_barrier()
#define PG8_SCHED __builtin_amdgcn_sched_barrier(0)
    Unit cur, nxt; int ui = 0;
    if (!S.next(0, cur)) return;
    f32x4 acc[2][2][4][2];
#pragma unroll
    for (int a = 0; a < 2; ++a)
#pragma unroll
        for (int b = 0; b < 2; ++b)
#pragma unroll
            for (int m = 0; m < 4; ++m)
#pragma unroll
                for (int n = 0; n < 2; ++n) acc[a][b][m][n] = (f32x4){0.f, 0.f, 0.f, 0.f};
    bf16x8 At[4][2], B0[2][2], B1[2][2];
    const char* cA = (const char*)g.A + (size_t)cur.pm * tstepA; const char* cB = (const char*)g.Bt + (size_t)cur.pn * tstepB;
    S.a_ready(cur);
    if constexpr (SP2) {
        PG8_STAGE(PG8_SB(0, 0), cB, voffB); PG8_STAGE(PG8_SB(0, 1), cB + hstepB, voffB); PG8_STAGE(PG8_SA(0, 0), cA, voffA); PG8_STAGE(PG8_SA(0, 1), cA + hstepA, voffA);
        if (wr == 1) PG8_BAR;
        PG8_WAIT_V(2); PG8_BAR;
        PG8_STAGE(PG8_SB(1, 0), cB + kstep, voffB); PG8_STAGE(PG8_SA(1, 0), cA + kstep, voffA); PG8_STAGE(PG8_SB(1, 1), cB + hstepB + kstep, voffB);
        PG8_WAIT_V(6); PG8_BAR;
    } else {
        PG8_STAGE(PG8_SB(0, 0), cB, voffB); PG8_STAGE(PG8_SA(0, 0), cA, voffA); PG8_STAGE(PG8_SB(0, 1), cB + hstepB, voffB); PG8_STAGE(PG8_SA(0, 1), cA + hstepA, voffA);
        if (wr == 1) PG8_BAR;
        PG8_WAIT_V(4); PG8_BAR;
        PG8_STAGE(PG8_SB(1, 0), cB + kstep, voffB); PG8_STAGE(PG8_SA(1, 0), cA + kstep, voffA); PG8_STAGE(PG8_SB(1, 1), cB + hstepB + kstep, voffB);
        PG8_WAIT_V(6); PG8_BAR;
    }
    for (;;) {
        const bool has_next = S.next(ui + 1, nxt);
        const char* nA = has_next ? (const char*)g.A + (size_t)nxt.pm * tstepA : cA; const char* nB = has_next ? (const char*)g.Bt + (size_t)nxt.pn * tstepB : cB;
        for (int t = 0; t < nt; t += 2) {
            const bool last = (t == nt - 2);
            const char* a1 = cA + PG8_KOFF(t + 1);
            const char* a2 = last ? nA : cA + PG8_KOFF(t + 2); const char* b2 = last ? nB : cB + (size_t)(t + 2) * kstep;
            const char* a3 = a2 + kstep; const char* b3 = b2 + kstep;
            if (last && has_next) S.a_ready(nxt);
            if constexpr (SP2) {
            PG8_LDB(B0, 0, 0); PG8_LDB(B1, 0, 1); PG8_SCHED; PG8_LDA(At, 0, 0); PG8_STAGE(PG8_SA(1, 1), a1 + hstepA, voffA);
            PG8_WAIT_V(8); PG8_WAIT_L(0); PG8_BAR; PG8_MMA(0, 0, At, B0); PG8_MMA(0, 1, At, B1); PG8_BAR; PG8_SCHED;
            PG8_LDA(At, 0, 1); PG8_STAGE(PG8_SB(0, 0), b2, voffB); PG8_STAGE(PG8_SB(0, 1), b2 + hstepB, voffB); PG8_STAGE(PG8_SA(0, 0), a2, voffA);
            PG8_WAIT_V(8); PG8_WAIT_L(0); PG8_BAR; PG8_MMA(1, 0, At, B0); PG8_MMA(1, 1, At, B1); PG8_BAR; PG8_SCHED;
            PG8_LDB(B0, 1, 0); PG8_LDB(B1, 1, 1); PG8_SCHED; PG8_LDA(At, 1, 0); PG8_STAGE(PG8_SA(0, 1), a2 + hstepA, voffA);
            PG8_WAIT_V(8); PG8_WAIT_L(0); PG8_BAR; PG8_MMA(0, 0, At, B0); PG8_MMA(0, 1, At, B1); PG8_BAR; PG8_SCHED;
            PG8_LDA(At, 1, 1); PG8_STAGE(PG8_SB(1, 0), b3, voffB); PG8_STAGE(PG8_SB(1, 1), b3 + hstepB, voffB); PG8_STAGE(PG8_SA(1, 0), a3, voffA);
            PG8_WAIT_V(8); PG8_WAIT_L(0); PG8_BAR; PG8_MMA(1, 0, At, B0); PG8_MMA(1, 1, At, B1); PG8_BAR; PG8_SCHED;
            } else {
            PG8_LDB(B0, 0, 0); PG8_SCHED; PG8_LDA(At, 0, 0); PG8_STAGE(PG8_SA(1, 1), a1 + hstepA, voffA);
            PG8_WAIT_L(8); PG8_BAR; PG8_WAIT_L(0); PG8_MMA(0, 0, At, B0); PG8_BAR; PG8_SCHED;
            PG8_LDB(B1, 0, 1); PG8_STAGE(PG8_SB(0, 0), b2, voffB);
            PG8_BAR; PG8_WAIT_L(0); PG8_MMA(0, 1, At, B1); PG8_BAR;
            PG8_LDA(At, 0, 1); PG8_STAGE(PG8_SA(0, 0), a2, voffA);
            PG8_BAR; PG8_WAIT_L(0); PG8_MMA(1, 0, At, B0); PG8_BAR; PG8_SCHED;
            PG8_STAGE(PG8_SB(0, 1), b2 + hstepB, voffB);
            PG8_WAIT_V(6); PG8_BAR; PG8_MMA(1, 1, At, B1); PG8_BAR;
            PG8_LDB(B0, 1, 0); PG8_SCHED; PG8_LDA(At, 1, 0); PG8_STAGE(PG8_SA(0, 1), a2 + hstepA, voffA);
            PG8_WAIT_L(8); PG8_BAR; PG8_WAIT_L(0); PG8_MMA(0, 0, At, B0); PG8_BAR; PG8_SCHED;
            PG8_LDB(B1, 1, 1); PG8_STAGE(PG8_SB(1, 0), b3, voffB);
            PG8_BAR; PG8_WAIT_L(0); PG8_MMA(0, 1, At, B1); PG8_BAR;
            PG8_LDA(At, 1, 1); PG8_STAGE(PG8_SA(1, 0), a3, voffA);
            PG8_BAR; PG8_WAIT_L(0); PG8_MMA(1, 0, At, B0); PG8_BAR; PG8_SCHED;
            PG8_STAGE(PG8_SB(1, 1), b3 + hstepB, voffB);
            PG8_WAIT_V(6); PG8_BAR; PG8_MMA(1, 1, At, B1); PG8_BAR;
            }
        }
        if constexpr (ALIGN_EPI) { if (wr == 0) PG8_BAR; }
        if constexpr (!Epi::AFTER_DRAIN) { E(acc, cur, wr, wc, fr, fq); S.done(cur); }
        if (!has_next) break;
#pragma unroll
        for (int a = 0; a < 2; ++a)
#pragma unroll
            for (int b = 0; b < 2; ++b)
#pragma unroll
                for (int m = 0; m < 4; ++m)
#pragma unroll
                    for (int n = 0; n < 2; ++n) acc[a][b][m][n] = (f32x4){0.f, 0.f, 0.f, 0.f};
        cur = nxt; cA = nA; cB = nB; ++ui;
        if constexpr (ALIGN_EPI) { if (wr == 1) PG8_BAR; }
    }
    PG8_WAIT_V(0);
    if constexpr (!ALIGN_EPI) { if (wr == 0) PG8_BAR; }
    PG8_BAR;
    if constexpr (Epi::AFTER_DRAIN) { E.fused(acc, cur, wr, wc, fr, fq, lds, wid, lane); S.done(cur); }
#undef PG8_SA
#undef PG8_KOFF
#undef PG8_SB
#undef PG8_STAGE
#undef PG8_LDA
#undef PG8_LDB
#undef PG8_MMA
#undef PG8_WAIT_V
#undef PG8_WAIT_L
#undef PG8_BAR
#undef PG8_SCHED
}
}
#include <hip/hip_bf16.h>
#include <cmath>
namespace attn_body {
using bf16=__hip_bfloat16;
using bf16x8=__attribute__((ext_vector_type(8)))short;
using s16x4=__attribute__((ext_vector_type(4)))short;
using f32x16=__attribute__((ext_vector_type(16)))float;
using u32x4=__attribute__((ext_vector_type(4)))unsigned;
constexpr int BATCH=16,NHEAD=16,SEQ=2048,D=64,DM=NHEAD*D;
constexpr int NW=8,QBLK=32,QB=QBLK*NW,KVBLK=64,NQB=SEQ/QB;
constexpr int ATTN_PITCH=DM, ATTN_UNIT_ROWS=QB;
__device__ __forceinline__ int crow(int r,int hi){return (r&3)+8*(r>>2)+4*hi;}
#define SBAR() __builtin_amdgcn_sched_barrier(0)
__device__ __forceinline__ void cmask(f32x16&p0,f32x16&p1,int jb,int qrel,int hi){
  const float NEG=-INFINITY; int kb=64*jb+4*hi;
  #pragma unroll
  for(int r=0;r<16;++r){int kv=kb+(r&3)+8*(r>>2); if(kv>qrel)p0[r]=NEG; if(kv+32>qrel)p1[r]=NEG;}
}

constexpr int NSLOT=3, SLOTB=8192;
constexpr int LDS_K=0, LDS_V=NSLOT*SLOTB, LDS_WS=2*NSLOT*SLOTB, LDS_OST=LDS_WS+NW*64*4, LDS_BYTES=LDS_OST+NW*4096;
constexpr float C2=0.125f*1.4426950408889634f;
__device__ __forceinline__ void glds16(const void*gsrc,unsigned lds_dst){unsigned keep;
  asm volatile("s_mov_b32 %0, m0\n\ts_mov_b32 m0, %2\n\ts_nop 0\n\tglobal_load_lds_dwordx4 %1, off\n\ts_mov_b32 m0, %0":"=&s"(keep):"v"(gsrc),"s"(lds_dst):"memory");}
__device__ __forceinline__ float max3f(float a,float b,float c){float r;asm("v_max3_f32 %0, %1, %2, %3":"=v"(r):"v"(a),"v"(b),"v"(c));return r;}
__device__ __forceinline__ float max2f(float a,float b){float r;asm("v_max_f32_e32 %0, %1, %2":"=v"(r):"v"(a),"v"(b));return r;}
__device__ __forceinline__ float fadd_s(float a,float b){float r;asm("v_add_f32_e32 %0, %1, %2":"=v"(r):"v"(a),"v"(b));return r;}
__device__ __forceinline__ float fsub_s(float a,float b){float r;asm("v_sub_f32_e32 %0, %1, %2":"=v"(r):"v"(a),"v"(b));return r;}
typedef float f32x2_t __attribute__((ext_vector_type(2))); typedef __bf16 bf16x2_t __attribute__((ext_vector_type(2)));
__device__ __forceinline__ unsigned cvtpk_s(float lo,float hi){f32x2_t v={lo,hi};bf16x2_t b=__builtin_convertvector(v,bf16x2_t);return __builtin_bit_cast(unsigned,b);}
#define WAIT_BAR(N) asm volatile("s_waitcnt vmcnt(" #N ") lgkmcnt(0)\n\ts_barrier":::"memory")

__device__ __forceinline__ void qkt(f32x16&p0,f32x16&p1,const char*Kslot,const bf16x8*qr,int r32,int hi,s16x4 ka0,s16x4 ka1,s16x4 qaug){
  const f32x16 zero=f32x16{};
  const char*kb=Kslot+hi*1024+r32*16;
  #pragma unroll
  for(int d0=0;d0<4;++d0){
    const bf16x8 b0=*reinterpret_cast<const bf16x8*>(kb+d0*2048);
    const bf16x8 b1=*reinterpret_cast<const bf16x8*>(kb+d0*2048+512);
    if(d0==0){p0=__builtin_amdgcn_mfma_f32_32x32x16_bf16(b0,qr[0],zero,0,0,0);p1=__builtin_amdgcn_mfma_f32_32x32x16_bf16(b1,qr[0],zero,0,0,0);}
    else{p0=__builtin_amdgcn_mfma_f32_32x32x16_bf16(b0,qr[d0],p0,0,0,0);p1=__builtin_amdgcn_mfma_f32_32x32x16_bf16(b1,qr[d0],p1,0,0,0);}}
  p0=__builtin_amdgcn_mfma_f32_32x32x8bf16_1k(ka0,qaug,p0,0,0,0);p1=__builtin_amdgcn_mfma_f32_32x32x8bf16_1k(ka1,qaug,p1,0,0,0);
}
typedef __attribute__((address_space(3))) const char* lds_cptr;
typedef short v4i16_t __attribute__((ext_vector_type(4)));
__device__ __forceinline__ void kload8(bf16x8*kf,lds_cptr kp){
  kf[0]=*(const __attribute__((address_space(3))) bf16x8*)(kp);      kf[1]=*(const __attribute__((address_space(3))) bf16x8*)(kp+512);
  kf[2]=*(const __attribute__((address_space(3))) bf16x8*)(kp+2048); kf[3]=*(const __attribute__((address_space(3))) bf16x8*)(kp+2560);
  kf[4]=*(const __attribute__((address_space(3))) bf16x8*)(kp+4096); kf[5]=*(const __attribute__((address_space(3))) bf16x8*)(kp+4608);
  kf[6]=*(const __attribute__((address_space(3))) bf16x8*)(kp+6144); kf[7]=*(const __attribute__((address_space(3))) bf16x8*)(kp+6656);
}
__device__ __forceinline__ void kload2(bf16x8*kf,lds_cptr kp,int j){ kf[2*j]=*(const __attribute__((address_space(3))) bf16x8*)(kp+j*2048); kf[2*j+1]=*(const __attribute__((address_space(3))) bf16x8*)(kp+j*2048+512); }
__device__ __forceinline__ s16x4 vtr(lds_cptr p){ return __builtin_bit_cast(s16x4,__builtin_amdgcn_ds_read_tr16_b64_v4i16((__attribute__((address_space(3))) v4i16_t*)p)); }
__device__ __forceinline__ float rowmax(const f32x16&p0,const f32x16&p1){
  float a=max3f(p0[0],p0[1],p1[0]),b=max3f(p0[2],p0[3],p1[1]);a=max3f(a,p1[2],p1[3]);
  #pragma unroll
  for(int r=4;r<16;r+=4){a=max3f(a,p0[r],p0[r+1]);b=max3f(b,p0[r+2],p0[r+3]);a=max3f(a,p1[r],p1[r+1]);b=max3f(b,p1[r+2],p1[r+3]);}
  const float m=max2f(a,b);
  auto rr=__builtin_amdgcn_permlane32_swap(__float_as_uint(m),__float_as_uint(m),false,false);
  return max2f(__uint_as_float(rr[0]),__uint_as_float(rr[1]));
}
__device__ __forceinline__ void pv(f32x16*o,int vb,bf16x8 pa0,bf16x8 pa1,bf16x8 pa2,bf16x8 pa3){
  #pragma unroll
  for(int d0=0;d0<2;++d0){s16x4 lo[4],hi[4];
    #pragma unroll
    for(int ks=0;ks<4;++ks){
      asm volatile("ds_read_b64_tr_b16 %0,%1 offset:%c2":"=&v"(lo[ks]):"v"(vb),"i"(d0*4096+ks*1024):"memory");
      asm volatile("ds_read_b64_tr_b16 %0,%1 offset:%c2":"=&v"(hi[ks]):"v"(vb),"i"(d0*4096+ks*1024+512):"memory");}
    asm volatile("s_waitcnt lgkmcnt(0)":::"memory");SBAR();
    #define PK(k) (bf16x8){lo[k][0],lo[k][1],lo[k][2],lo[k][3],hi[k][0],hi[k][1],hi[k][2],hi[k][3]}
    o[d0]=__builtin_amdgcn_mfma_f32_32x32x16_bf16(pa0,PK(0),o[d0],0,0,0);
    o[d0]=__builtin_amdgcn_mfma_f32_32x32x16_bf16(pa1,PK(1),o[d0],0,0,0);
    o[d0]=__builtin_amdgcn_mfma_f32_32x32x16_bf16(pa2,PK(2),o[d0],0,0,0);
    o[d0]=__builtin_amdgcn_mfma_f32_32x32x16_bf16(pa3,PK(3),o[d0],0,0,0);
    #undef PK
  }
}

#ifndef ATTN_STORE16
#define ATTN_STORE16(p,v) (*(u32x4*)(p)=(v))
#endif
template<int THRL> __device__ __forceinline__ void attn_unit(int b,int h,int qb,int ts,const bf16*Q,const bf16*__restrict__ K,const bf16*__restrict__ V,bf16*O,const bf16*__restrict__ GF,char*shm,lds_cptr btab){
  int tid_=threadIdx.x; asm volatile("":"+v"(tid_)); const int tid=tid_,lane=tid&63,r32=lane&31,hi=lane>>5; const int wid=__builtin_amdgcn_readfirstlane(tid>>6);
  const long rowbase=(long)b*SEQ; const int q0=qb*QB;
  const bf16*Qw=Q+(rowbase+q0+wid*QBLK)*DM+h*D;
  const bf16*Kh=K+(rowbase+(long)ts*KVBLK)*DM+h*D,*Vh=V+(rowbase+(long)ts*KVBLK)*DM+h*D;
  const unsigned lds0=(unsigned)(uintptr_t)shm;
  float*wsf=(float*)(shm+LDS_WS)+wid*64;
  const bf16*ksrc=Kh+(long)lane*DM+wid*8;
  const bf16*vsrc=Vh+(long)(16*(wid&3)+(lane>>2))*DM+(wid>>2)*32+(lane&3)*8;
  const unsigned kdst=lds0+LDS_K+wid*1024, vdst=lds0+LDS_V+wid*1024;
  #define DMA_K(t,slot) glds16(ksrc+(long)(t)*KVBLK*DM,(unsigned)__builtin_amdgcn_readfirstlane(kdst+(slot)))
  #define DMA_V(t,slot) glds16(vsrc+(long)(t)*KVBLK*DM,(unsigned)__builtin_amdgcn_readfirstlane(vdst+(slot)))
  const int vb0=(int)(lds0+LDS_V)+((lane>>4)&1)*32+(lane&3)*8+(4*hi+((lane&15)>>2))*64;
  const char*Kbase=shm+LDS_K; bf16x8 kf[8];
  const lds_cptr shm3=(lds_cptr)shm; const lds_cptr kp0=shm3+LDS_K+hi*1024+r32*16; const lds_cptr vp0=shm3+LDS_V+((lane>>4)&1)*32+(lane&3)*8+(4*hi+((lane&15)>>2))*64;
  const int NT=(q0+QB)/KVBLK-ts;
  DMA_K(0,0);DMA_V(0,0);DMA_K(1,SLOTB);
  bf16x8 qr[4];
  #pragma unroll
  for(int d0=0;d0<4;++d0)qr[d0]=*reinterpret_cast<const bf16x8*>(&Qw[(long)r32*DM+d0*16+hi*8]);
  typedef unsigned u32x2_t __attribute__((ext_vector_type(2)));
  const lds_cptr bt0=btab+ts*(KVBLK*16)+r32*16+hi*8;
  #define KAUG(t,half) __builtin_bit_cast(s16x4,*(const __attribute__((address_space(3))) u32x2_t*)(bt0+((t)*64+(half)*32)*16))
  u32x2_t qaw=hi?(u32x2_t){0u,0u}:(u32x2_t){0x3F803F80u,0x00003F80u};
  #define QAUG __builtin_bit_cast(s16x4,qaw)
  #define SETQ() do{ const float nm_=-mhat; const unsigned m1_=cvtpk_s(nm_,0.f)&0xffffu; const float r1_=nm_-__uint_as_float(m1_<<16); const unsigned m2_=cvtpk_s(r1_,0.f)&0xffffu; const float r2_=r1_-__uint_as_float(m2_<<16); \
    const unsigned m3_=cvtpk_s(r2_,0.f)&0xffffu; qaw=hi?(u32x2_t){m2_|(m3_<<16),0u}:(u32x2_t){0x3F803F80u,0x3F80u|(m1_<<16)}; }while(0)
  typedef unsigned u32x2_t __attribute__((ext_vector_type(2)));
  float mhat=0.f,l_reg=0.f;f32x16 o[2];o[0]=f32x16{};o[1]=f32x16{};const f32x16 zero16=f32x16{};
  const int qrel=wid*QBLK+r32;
  #define CMASK(P0,P1,t) do{int jb_=(t)-(NT-4); if(jb_>=0)cmask(P0,P1,jb_,qrel,hi);}while(0)
  bool resc=false;
  #define START(P0,P1) do{ const float rm=rowmax(P0,P1); resc=false; \
    { const float dl=rm; mhat=fadd_s(mhat,dl); \
      _Pragma("unroll") for(int r=0;r<16;++r){P0[r]=fsub_s(P0[r],dl);P1[r]=fsub_s(P1[r],dl);} \
      SETQ(); } \
    _Pragma("unroll") for(int r=0;r<16;++r)P0[r]=__builtin_amdgcn_exp2f(P0[r]); }while(0)
  #define RESC() do{ if(resc){ asm volatile("s_waitcnt lgkmcnt(0)":::"memory"); \
      _Pragma("unroll") for(int d_=0;d_<2;++d_) _Pragma("unroll") for(int r=0;r<16;++r)o[d_][r]*=wsf[crow(r,hi)]; } }while(0)
  f32x16 pA0,pA1,pB0,pB1;
  int sl_prev=0,sl_cur=0,sl_next=SLOTB;
  #define ROT() do{sl_prev=sl_cur;sl_cur=sl_next;sl_next=(sl_next==(NSLOT-1)*SLOTB)?0:sl_next+SLOTB;}while(0)
  DMA_K(2,2*SLOTB);
  WAIT_BAR(3);
  qkt(pA0,pA1,Kbase,qr,r32,hi,KAUG(0,0),KAUG(0,1),QAUG);asm volatile("s_nop 15\n\ts_nop 7":"+v"(pA0),"+v"(pA1));CMASK(pA0,pA1,0);
  START(pA0,pA1);
  _Pragma("unroll") for(int r=0;r<16;++r)pA1[r]=__builtin_amdgcn_exp2f(pA1[r]);
  WAIT_BAR(0);
  DMA_K(3,0);DMA_V(1,SLOTB);
  ROT();
  kload8(kf,kp0+sl_cur);
  WAIT_BAR(2);
  s16x4 vlo[8],vhi[8]; u32x4 pw0,pw1,pw2,pw3;
  #define PKW(P,B) cvtpk_s(P[B],P[B+1])
  #define PAF(k) __builtin_bit_cast(bf16x8,pw##k)
  #define VFR(i) (bf16x8){vlo[i][0],vlo[i][1],vlo[i][2],vlo[i][3],vhi[i][0],vhi[i][1],vhi[i][2],vhi[i][3]}
  #define PIN(x) asm volatile("":"+v"(x))
  #define MX3(a,b,c) __builtin_fmaxf(__builtin_fmaxf((a),(b)),(c))
  #define GAPA(MF,A0,A1,A2,A3,W0,W1,PW) do{ MF; sacc+=A0; sacc+=A1; sacc+=A2; sacc+=A3; PIN(sacc); W0; W1; PIN(PW); SBAR(); }while(0)
  #define EX(v) __builtin_amdgcn_exp2f(v)
  #define GAPB(MF,X,B) do{ MF; X[B]=EX(X[B]); X[B+1]=EX(X[B+1]); X[B+2]=EX(X[B+2]); X[B+3]=EX(X[B+3]); PIN(X); SBAR(); }while(0)
  #define VRD(i) do{ vlo[i]=vtr(vp_+(((i)>>2)*4096+((i)&3)*1024)); vhi[i]=vtr(vp_+(((i)>>2)*4096+((i)&3)*1024+512)); }while(0)
  #define KRD(G,j) do{ if(G){ kload2(kf,kp0+sl_next,j); SBAR(); } }while(0)
  #define STEP(C0,C1,P0,P1,t,GK,GV,GL) do{ SBAR(); \
    const lds_cptr vp_=vp0+sl_prev; const s16x4 ka0_=KAUG(t,0),ka1_=KAUG(t,1); \
    VRD(0); SBAR(); float sacc=(P0[0]+P0[1]); \
    GAPA(C0=__builtin_amdgcn_mfma_f32_32x32x16_bf16(kf[0],qr[0],zero16,0,0,0), P0[2],P0[3],P0[4],P0[5],     pw0[0]=PKW(P0,0), pw0[1]=PKW(P0,2), pw0); \
    VRD(4); SBAR(); GAPA(C1=__builtin_amdgcn_mfma_f32_32x32x16_bf16(kf[1],qr[0],zero16,0,0,0), P0[6],P0[7],P0[8],P0[9],     pw0[2]=PKW(P0,4), pw0[3]=PKW(P0,6), pw0); \
    VRD(1); SBAR(); GAPA(C0=__builtin_amdgcn_mfma_f32_32x32x16_bf16(kf[2],qr[1],C0,0,0,0),   P0[10],P0[11],P0[12],P0[13], pw1[0]=PKW(P0,8), pw1[1]=PKW(P0,10), pw1); \
    VRD(5); SBAR(); GAPA(C1=__builtin_amdgcn_mfma_f32_32x32x16_bf16(kf[3],qr[1],C1,0,0,0),   P0[14],P0[15],P1[0],P1[1],   pw1[2]=PKW(P0,12),pw1[3]=PKW(P0,14), pw1); \
    VRD(2); SBAR(); GAPA(C0=__builtin_amdgcn_mfma_f32_32x32x16_bf16(kf[4],qr[2],C0,0,0,0),   P1[2],P1[3],P1[4],P1[5],     pw2[0]=PKW(P1,0), pw2[1]=PKW(P1,2), pw2); \
    VRD(6); SBAR(); GAPA(C1=__builtin_amdgcn_mfma_f32_32x32x16_bf16(kf[5],qr[2],C1,0,0,0),   P1[6],P1[7],P1[8],P1[9],     pw2[2]=PKW(P1,4), pw2[3]=PKW(P1,6), pw2); \
    VRD(3); SBAR(); GAPA(C0=__builtin_amdgcn_mfma_f32_32x32x16_bf16(kf[6],qr[3],C0,0,0,0),   P1[10],P1[11],P1[12],P1[13], pw3[0]=PKW(P1,8), pw3[1]=PKW(P1,10), pw3); \
    VRD(7); SBAR(); GAPA(C1=__builtin_amdgcn_mfma_f32_32x32x16_bf16(kf[7],qr[3],C1,0,0,0),   P1[14],P1[15],0.f,0.f,       pw3[2]=PKW(P1,12),pw3[3]=PKW(P1,14), pw3); \
    C0=__builtin_amdgcn_mfma_f32_32x32x8bf16_1k(ka0_,QAUG,C0,0,0,0); C1=__builtin_amdgcn_mfma_f32_32x32x8bf16_1k(ka1_,QAUG,C1,0,0,0); \
    l_reg+=sacc; \
    if(GK){DMA_K((t)+3,sl_cur);} if(GV){DMA_V((t)+1,sl_next);} \
    CMASK(C0,C1,t); \
    { float a=MX3(C0[0],C0[1],C1[0]),b=MX3(C0[2],C0[3],C1[1]); a=MX3(a,C1[2],C1[3]); \
      _Pragma("unroll") for(int r=4;r<16;r+=4){a=MX3(a,C0[r],C0[r+1]);b=MX3(b,C0[r+2],C0[r+3]);a=MX3(a,C1[r],C1[r+1]);b=MX3(b,C1[r+2],C1[r+3]);} \
      float rm=__builtin_fmaxf(a,b); { auto rr=__builtin_amdgcn_permlane32_swap(__float_as_uint(rm),__float_as_uint(rm),false,false); rm=__builtin_fmaxf(__uint_as_float(rr[0]),__uint_as_float(rr[1])); } \
      resc=false; \
      if(__builtin_expect(__any(rm>(float)THRL),0)){ const float dl=__builtin_fmaxf(rm,0.f); mhat+=dl; \
        _Pragma("unroll") for(int r=0;r<16;++r){C0[r]-=dl;C1[r]-=dl;} \
        SETQ(); \
        const float f=__builtin_amdgcn_exp2f(-dl); l_reg*=f; if(hi==0)wsf[r32]=f; resc=true; } } \
    SBAR(); \
    GAPB(o[0]=__builtin_amdgcn_mfma_f32_32x32x16_bf16(PAF(0),VFR(0),o[0],0,0,0), C0,0); \
    GAPB(o[1]=__builtin_amdgcn_mfma_f32_32x32x16_bf16(PAF(0),VFR(4),o[1],0,0,0), C0,4); \
    KRD(GL,0); GAPB(o[0]=__builtin_amdgcn_mfma_f32_32x32x16_bf16(PAF(1),VFR(1),o[0],0,0,0), C0,8); \
    KRD(GL,1); GAPB(o[1]=__builtin_amdgcn_mfma_f32_32x32x16_bf16(PAF(1),VFR(5),o[1],0,0,0), C0,12); \
    KRD(GL,2); GAPB(o[0]=__builtin_amdgcn_mfma_f32_32x32x16_bf16(PAF(2),VFR(2),o[0],0,0,0), C1,0); \
    KRD(GL,3); GAPB(o[1]=__builtin_amdgcn_mfma_f32_32x32x16_bf16(PAF(2),VFR(6),o[1],0,0,0), C1,4); \
    GAPB(o[0]=__builtin_amdgcn_mfma_f32_32x32x16_bf16(PAF(3),VFR(3),o[0],0,0,0), C1,8); \
    GAPB(o[1]=__builtin_amdgcn_mfma_f32_32x32x16_bf16(PAF(3),VFR(7),o[1],0,0,0), C1,12); \
    }while(0)
  int t=1;
  #undef CMASK
  #define CMASK(P0,P1,t) do{}while(0)
  for(;t+5<NT;t+=2){
    STEP(pB0,pB1,pA0,pA1,t,true,true,true);     WAIT_BAR(2); RESC(); ROT();
    STEP(pA0,pA1,pB0,pB1,t+1,true,true,true);   WAIT_BAR(2); RESC(); ROT();
  }
  #undef CMASK
  #define CMASK(P0,P1,t) do{int jb_=(t)-(NT-4); if(jb_>=0)cmask(P0,P1,jb_,qrel,hi);}while(0)
  #define ENDW(tt) do{ if((tt)+3<NT){WAIT_BAR(2);} else if((tt)+2<NT){WAIT_BAR(1);} else {WAIT_BAR(0);} }while(0)
  for(;t+1<NT;t+=2){
    STEP(pB0,pB1,pA0,pA1,t,(t+3<NT),(t+1<NT),(t+1<NT));       ENDW(t);   RESC(); ROT();
    STEP(pA0,pA1,pB0,pB1,t+1,(t+4<NT),(t+2<NT),(t+2<NT));     ENDW(t+1); RESC(); ROT();
  }
  #define DRAIN(P0,P1,slot) do{ float sacc=P0[0]+P0[1]; _Pragma("unroll") for(int r=2;r<16;++r)sacc+=P0[r]; _Pragma("unroll") for(int r=0;r<16;++r)sacc+=P1[r]; l_reg+=sacc; \
    pw0=(u32x4){PKW(P0,0),PKW(P0,2),PKW(P0,4),PKW(P0,6)};pw1=(u32x4){PKW(P0,8),PKW(P0,10),PKW(P0,12),PKW(P0,14)};pw2=(u32x4){PKW(P1,0),PKW(P1,2),PKW(P1,4),PKW(P1,6)};pw3=(u32x4){PKW(P1,8),PKW(P1,10),PKW(P1,12),PKW(P1,14)}; \
    SBAR(); pv(o,vb0+(slot),PAF(0),PAF(1),PAF(2),PAF(3)); }while(0)
  if(wid>=6){ STEP(pB0,pB1,pA0,pA1,NT-1,false,false,false); RESC(); DRAIN(pB0,pB1,sl_cur); }
  else if(wid>=4){ DRAIN(pA0,pA1,sl_prev); }
  #undef DRAIN
  #undef PKW
  #undef PAF
  #undef VFR
  #undef PIN
  #undef MX3
  #undef GAPA
  #undef GAPB
  #undef EX
  #undef VRD
  #undef KRD
  #undef STEP
  #undef ENDW
  {auto rr=__builtin_amdgcn_permlane32_swap(__float_as_uint(l_reg),__float_as_uint(l_reg),false,false);l_reg=__uint_as_float(rr[0])+__uint_as_float(rr[1]);}
  if(hi==0)wsf[32+r32]=l_reg;asm volatile("s_waitcnt lgkmcnt(0)":::"memory");
  float rli[16];
  #pragma unroll
  for(int r=0;r<16;++r)rli[r]=__builtin_amdgcn_rcpf(wsf[32+crow(r,hi)]);
  bf16*Ow=O+(rowbase+q0+wid*QBLK)*DM+h*D; const bf16*Gw=GF+(rowbase+q0+wid*QBLK)*DM+h*D;
  u32x4 gv[4];
  #pragma unroll
  for(int i=0;i<4;++i){const int row=i*8+(lane>>3),ch=lane&7; gv[i]=*(const u32x4*)(Gw+(long)row*DM+ch*8);}
  { bf16*stg=(bf16*)(shm+LDS_OST)+wid*2048;
    #pragma unroll
    for(int r=0;r<16;++r){const int orow=crow(r,hi);
      #pragma unroll
      for(int d0=0;d0<2;++d0)stg[orow*64+d0*32+r32]=__float2bfloat16(o[d0][r]*rli[r]);}
    asm volatile("s_waitcnt lgkmcnt(0)":::"memory");
    #pragma unroll
    for(int i=0;i<4;++i){const int row=i*8+(lane>>3),ch=lane&7; u32x4 v=*(const u32x4*)(stg+row*64+ch*8);
      #pragma unroll
      for(int j=0;j<4;++j){const unsigned a=v[j],g=gv[i][j]; v[j]=cvtpk_s(__uint_as_float(a<<16)*__uint_as_float(g<<16),__uint_as_float(a&0xffff0000u)*__uint_as_float(g&0xffff0000u));}
      ATTN_STORE16(Ow+(long)row*DM+ch*8,v);} }
  asm volatile("s_waitcnt lgkmcnt(0)\n\ts_barrier":::"memory");
  #undef DMA_K
  #undef KAUG
  #undef QAUG
  #undef SETQ
  #undef DMA_V
  #undef CMASK
  #undef START
  #undef RESC
  #undef ROT
}
constexpr int ATTN_LDS_BYTES=LDS_BYTES;
struct AttnTensors { const bf16* Q; const bf16* K; const bf16* V; bf16* O; const bf16* GF; };
#undef SBAR
#undef WAIT_BAR
}
constexpr int NWAVES = 8;
constexpr int BATCH = 16, SEQ = 2048, DMODEL = 1024, NH = 16, HD = 64, CK = 31;
constexpr int M = BATCH * SEQ;
constexpr int IN_COLS = 7184;
constexpr int O_Q = 0, O_K = 1024, O_V = 2048, O_F = 3072, O_GF = 3088, O_GLU = 4112, O_GC = 6160;
constexpr int N1 = 28 * 256;
constexpr int K2 = 2048;
constexpr size_t MiB = 1u << 20;
constexpr int CW_CONV = 3520;
constexpr size_t WS_CTL = 0, CTL_ZERO_BYTES = 16384;
constexpr size_t WS_BT1 = 2 * MiB;
constexpr size_t WS_BT2 = 18 * MiB;
constexpr size_t WS_RS = 26 * MiB;
constexpr size_t WS_LF = 24 * MiB;
constexpr size_t WS_XN = 32 * MiB;
constexpr size_t WS_Q = 96 * MiB, WS_K = 160 * MiB, WS_V = 224 * MiB, WS_GF = 288 * MiB, WS_U = 352 * MiB, WS_GC = 416 * MiB, WS_END = 480 * MiB;
constexpr int RING_BYTES = 131072;
constexpr int LDS_BYTES = 151552;
constexpr int BT_OFF = 98304, BT_BYTES = 32768, WT_OFF = BT_OFF + BT_BYTES;
constexpr int MISC_OFF = WT_OFF + 128;
constexpr int ESTG_OFF = WT_OFF + 512, ESTG_BYTES = 8 * 2304;
static_assert(ESTG_OFF + ESTG_BYTES <= LDS_BYTES, "LDS map");
static_assert(attn_body::ATTN_LDS_BYTES <= BT_OFF && MISC_OFF + 64 <= LDS_BYTES, "LDS map");

#define GAS __attribute__((address_space(1)))
#define LAS __attribute__((address_space(3)))
typedef unsigned short bf16;
typedef unsigned v4u __attribute__((ext_vector_type(4)));
typedef unsigned v2u __attribute__((ext_vector_type(2)));
typedef float f32x4 __attribute__((ext_vector_type(4)));
typedef float f32x2 __attribute__((ext_vector_type(2)));
__device__ __forceinline__ unsigned f2bf(float f) { unsigned u = __builtin_bit_cast(unsigned, f); return (u + 0x7fffu + ((u >> 16) & 1u)) >> 16; }
__device__ __forceinline__ unsigned pk2(float lo, float hi) { return f2bf(lo) | (f2bf(hi) << 16); }
__device__ __forceinline__ float bf_lo(unsigned w) { return __uint_as_float(w << 16); }
__device__ __forceinline__ float bf_hi(unsigned w) { return __uint_as_float(w & 0xffff0000u); }
__device__ __forceinline__ float wave_sum(float v) {
#pragma unroll
    for (int o = 1; o < 64; o <<= 1) v += __shfl_xor(v, o);
    return v;
}
struct Args { const float* in[11]; float* out; unsigned char* ws; int ph_lo, ph_hi; };
typedef const __attribute__((address_space(4))) Args* KArgs;

#define RLX_AGENT __ATOMIC_RELAXED, __HIP_MEMORY_SCOPE_AGENT
#define LDS_WAIT() asm volatile("s_waitcnt lgkmcnt(0)" ::: "memory")
#define VM_WAIT() asm volatile("s_waitcnt vmcnt(0)" ::: "memory")
#define XB_TMO      128
#define XB_XCNT(j)  (256  + 64 * (j))
#define XB_XSUB(j)  (1280 + 64 * (j))
#define XB_XGEN(j)  (2304 + 64 * (j))
#define XB_TOP      3328
#define XB_TOPGEN   3392
#define XCD_BAR_WORDS 3456
#define XB_SPIN_CAP (1u << 18)

__device__ __forceinline__ unsigned xb_ld(unsigned* p)              { return __hip_atomic_load(p, __ATOMIC_RELAXED, __HIP_MEMORY_SCOPE_AGENT); }
__device__ __forceinline__ unsigned xb_add(unsigned* p, unsigned v) { return __hip_atomic_fetch_add(p, v, __ATOMIC_RELAXED, __HIP_MEMORY_SCOPE_AGENT); }
__device__ __forceinline__ unsigned xb_xcc_id() { return (unsigned)__builtin_amdgcn_s_getreg((3 << 11) | 20) & 0xFu; }
#define XB_SPIN(cond, bar) do { unsigned _sp = 0; while (cond) { __builtin_amdgcn_s_sleep(1); \
    if ((++_sp & 255u) == 0u) { if (xb_ld(&(bar)[XB_TMO])) break; if (_sp > XB_SPIN_CAP) { atomicAdd(&(bar)[XB_TMO], 1u); break; } } } } while (0)

struct XcdBarrier {
    unsigned* bar; unsigned x;
    volatile LAS unsigned* st;
};

__device__ __forceinline__ XcdBarrier xcd_barrier_post(unsigned* bar, volatile LAS unsigned* st) {
    XcdBarrier b; b.bar = bar; b.x = xb_xcc_id(); b.st = st;
    if (threadIdx.x == 0) (void)xb_add(&bar[XB_XCNT(b.x)], 1u);
    return b;
}
__device__ __forceinline__ void xcd_barrier_complete(unsigned* bar, unsigned x, unsigned& nloc, unsigned& nx) {
    const unsigned G = gridDim.x * gridDim.y * gridDim.z;
    unsigned sum, cnt, mine, sp = 0u;
    for (;;) {
        sum = 0u; cnt = 0u; mine = 0u;
#pragma unroll
        for (unsigned j = 0; j < 16; ++j) { const unsigned c = xb_ld(&bar[XB_XCNT(j)]); sum += c; cnt += (c > 0u) ? 1u : 0u; mine = (j == x) ? c : mine; }
        if (sum == G) break;
        __builtin_amdgcn_s_sleep(1);
        if ((++sp & 255u) == 0u) { if (xb_ld(&bar[XB_TMO])) break; if (sp > XB_SPIN_CAP) { atomicAdd(&bar[XB_TMO], 1u); break; } }
    }
    nloc = mine > 0u ? mine : 1u; nx = cnt > 0u ? cnt : 1u;
}

__device__ __forceinline__ void xcd_barrier(const XcdBarrier& b) {
    asm volatile("s_waitcnt vmcnt(0)" ::: "memory");
    __syncthreads();
    if (threadIdx.x == 0) {
        unsigned* bar = b.bar;
        __builtin_amdgcn_s_waitcnt(0);
        unsigned nloc = b.st[0], nx = b.st[1];
        if (nloc == 0u) { xcd_barrier_complete(bar, b.x, nloc, nx); b.st[0] = nloc; b.st[1] = nx; }
        const unsigned old = xb_add(&bar[XB_XSUB(b.x)], 1u);
        const unsigned gen = old / nloc;
        if (old + 1u == (gen + 1u) * nloc) {
            __builtin_amdgcn_fence(__ATOMIC_RELEASE, "agent");
            asm volatile("s_waitcnt vmcnt(0)" ::: "memory");
            const unsigned og = xb_add(&bar[XB_TOP], 1u);
            const unsigned tg = og / nx;
            if (og + 1u == (tg + 1u) * nx) xb_add(&bar[XB_TOPGEN], 1u);
            else XB_SPIN(xb_ld(&bar[XB_TOPGEN]) == tg, bar);
            __builtin_amdgcn_fence(__ATOMIC_ACQUIRE, "agent");
            xb_add(&bar[XB_XGEN(b.x)], 1u);
            asm volatile("s_waitcnt vmcnt(0)" ::: "memory");
        } else {
            XB_SPIN(xb_ld(&bar[XB_XGEN(b.x)]) == gen, bar);
            __builtin_amdgcn_fence(__ATOMIC_ACQUIRE, "agent");
            asm volatile("s_waitcnt vmcnt(0)" ::: "memory");
        }
    }
    __syncthreads();
}

__device__ __forceinline__ void p0_transpose_item(const float* __restrict__ W, int ldw, int src_col0, const float* __restrict__ gk, bool use_g, bf16* __restrict__ WT, int K, int dst_row0, int kb, LAS float* scr, int lane) {
    const int k0 = 64 * kb, c = lane & 31, kh = lane >> 5;
    const float* __restrict__ wp = W + (size_t)(k0 + kh) * ldw + src_col0 + c; const float* __restrict__ gp = gk + ((k0 + kh) & (DMODEL - 1));
    float v[32], gg[32];
#pragma unroll
    for (int i = 0; i < 32; ++i) { v[i] = wp[(size_t)(2 * i) * ldw]; gg[i] = gp[2 * i]; }
    asm volatile("" ::: "memory");
#pragma unroll
    for (int i = 0; i < 32; ++i) scr[(2 * i + kh) * 33 + c] = v[i] * (use_g ? gg[i] : 1.0f);
    asm volatile("s_waitcnt lgkmcnt(0)" ::: "memory");
    const int c8 = lane & 7;
#pragma unroll
    for (int j = 0; j < 4; ++j) { const int n = (lane >> 3) + 8 * j; const LAS float* s = scr + (8 * c8) * 33 + n;
        v4u o; o.x = pk2(s[0 * 33], s[1 * 33]); o.y = pk2(s[2 * 33], s[3 * 33]); o.z = pk2(s[4 * 33], s[5 * 33]); o.w = pk2(s[6 * 33], s[7 * 33]);
        *(v4u*)(WT + (size_t)(dst_row0 + n) * K + k0 + 8 * c8) = o; }
    asm volatile("s_waitcnt lgkmcnt(0)" ::: "memory");
}
__device__ __forceinline__ int bt1_src(int rg) {
    const int pn = rg >> 3, tcg = rg & 7, bj = tcg >> 2, wc = tcg & 3;
    if (pn < 4)  return O_Q + 256 * pn + 64 * wc + 32 * bj;
    if (pn < 8)  return O_K + 256 * (pn - 4) + 64 * wc + 32 * bj;
    if (pn < 12) return O_V + 256 * (pn - 8) + 64 * wc + 32 * bj;
    if (pn < 16) return O_GF + 256 * (pn - 12) + 64 * wc + 32 * bj;
    if (pn < 24) return O_GLU + 1024 * bj + 128 * (pn - 16) + 32 * wc;
    return O_GC + 256 * (pn - 24) + 64 * wc + 32 * bj;
}
__device__ __forceinline__ void p0_prologue(KArgs Ap, LAS unsigned char* lds, int vcu, int G, int tid, int wave, int lane) {
    LAS float* scr = (LAS float*)(lds + wave * 16384);
    const int gw = vcu * NWAVES + wave, NGW = G * NWAVES;
    const float* w_in = Ap->in[2]; const float* w_out = Ap->in[10]; const float* ng = Ap->in[1]; unsigned char* ws = Ap->ws;
    bf16* BT1 = (bf16*)(ws + WS_BT1); bf16* BT2 = (bf16*)(ws + WS_BT2);
    constexpr int I1 = (N1 / 32) * 16, I2 = (DMODEL / 32) * (K2 / 64);
    for (int it = gw; it < I1 + I2; it += NGW) {
        if (it < I1) { const int rg = it >> 4, kb = it & 15; p0_transpose_item(w_in, IN_COLS, bt1_src(rg), ng, true, BT1, DMODEL, rg * 32, kb, scr, lane); }
        else { const int r = it - I1, n32 = r >> 5, kb = r & 31; p0_transpose_item(w_out, DMODEL, n32 * 32, ng, false, BT2, K2, n32 * 32, kb, scr, lane); }
    }
    __syncthreads();
    LAS v4u* wf = (LAS v4u*)lds;
    for (int e = tid; e < 32 * 64; e += NWAVES * 64) { const int kk = e >> 6, l = e & 63, kb = 32 * kk + 8 * (l >> 4), hd = l & 15; float v[8];
#pragma unroll
        for (int i = 0; i < 8; ++i) v[i] = w_in[(size_t)(kb + i) * IN_COLS + O_F + hd] * ng[kb + i];
        wf[e] = (v4u){pk2(v[0], v[1]), pk2(v[2], v[3]), pk2(v[4], v[5]), pk2(v[6], v[7])}; }
    __syncthreads();
    const float* x = Ap->in[0]; const float* bfg = Ap->in[3]; bf16* XN = (bf16*)(ws + WS_XN); float* RS = (float*)(ws + WS_RS); float* LF = (float*)(ws + WS_LF);
    const int fr = lane & 15, fq = lane >> 4;
    for (int grp = gw; grp < M / 16; grp += NGW) {
        const int r0 = grp * 16;
        const f32x4* __restrict__ xp = (const f32x4*)(x + (size_t)(r0 + fr) * DMODEL + 8 * fq); v4u* __restrict__ op = (v4u*)(XN + (size_t)(r0 + fr) * DMODEL + 8 * fq);
        pg8::f32x4 acc = {0.f, 0.f, 0.f, 0.f}; float ss = 0.f;
        f32x4 cur[8][2], nxt[8][2];
#pragma unroll
        for (int j = 0; j < 8; ++j) { cur[j][0] = __builtin_nontemporal_load(xp + 8 * j); cur[j][1] = __builtin_nontemporal_load(xp + 8 * j + 1); }
#pragma unroll
        for (int kb8 = 0; kb8 < 32; kb8 += 8) {
            if (kb8 + 8 < 32) {
#pragma unroll
                for (int j = 0; j < 8; ++j) { nxt[j][0] = __builtin_nontemporal_load(xp + 8 * (kb8 + 8 + j)); nxt[j][1] = __builtin_nontemporal_load(xp + 8 * (kb8 + 8 + j) + 1); }
            }
            asm volatile("" ::: "memory");
#pragma unroll
            for (int j = 0; j < 8; ++j) { const int kk = kb8 + j; const f32x4 a0 = cur[j][0], a1 = cur[j][1];
                ss += (a0.x * a0.x + a0.y * a0.y) + (a0.z * a0.z + a0.w * a0.w) + (a1.x * a1.x + a1.y * a1.y) + (a1.z * a1.z + a1.w * a1.w);
                const v4u av = {attn_body::cvtpk_s(a0.x, a0.y), attn_body::cvtpk_s(a0.z, a0.w), attn_body::cvtpk_s(a1.x, a1.y), attn_body::cvtpk_s(a1.z, a1.w)};
                op[4 * kk] = av;
                acc = __builtin_amdgcn_mfma_f32_16x16x32_bf16(__builtin_bit_cast(pg8::bf16x8, av), __builtin_bit_cast(pg8::bf16x8, wf[kk * 64 + lane]), acc, 0, 0, 0); }
            asm volatile("" ::: "memory");
#pragma unroll
            for (int j = 0; j < 8; ++j) { cur[j][0] = nxt[j][0]; cur[j][1] = nxt[j][1]; }
        }
        ss += __shfl_xor(ss, 16); ss += __shfl_xor(ss, 32);
        const float rs = 1.0f / sqrtf(ss * (1.f / DMODEL) + pg8::kEPS);
        if (fq == 0) RS[r0 + fr] = rs;
        const float bb = bfg[fr];
#pragma unroll
        for (int e = 0; e < 4; ++e) { const int r = 4 * fq + e; const float z = __shfl(rs, r) * acc[e] + bb;
            LF[(size_t)(r0 + r) * 16 + fr] = fminf(z, 0.f) - log1pf(expf(-fabsf(z))); }
    }
}

__device__ __forceinline__ f32x2 unpk(unsigned w) { return (f32x2){bf_lo(w), bf_hi(w)}; }
__device__ __forceinline__ void conv_phase(KArgs Ap, LAS unsigned char* lds, int vcu, int G, int tid, int wave, int lane, size_t out_off) {
    (void)vcu; (void)G;
    LAS float* red = (LAS float*)lds;
    LAS f32x2* fin = (LAS f32x2*)(lds + 1024);
    const int c0 = 2 * tid;
    const float* cw = Ap->in[6]; unsigned char* ws = Ap->ws;
    f32x2 w[CK];
#pragma unroll
    for (int j = 0; j < CK; ++j) w[j] = *(const f32x2*)(cw + j * 1024 + c0);
    const f32x2 cb = *(const f32x2*)(Ap->in[7] + c0), lg = *(const f32x2*)(Ap->in[8] + c0), lb = *(const f32x2*)(Ap->in[9] + c0);
    const bf16* U = (const bf16*)(ws + WS_U); bf16* GC = (bf16*)(ws + WS_GC);
    unsigned* ctr = (unsigned*)(ws + WS_CTL) + CW_CONV; volatile LAS int* ubox = (volatile LAS int*)(lds + 2048);
    for (;;) {
        if (tid == 0) ubox[0] = (int)__hip_atomic_fetch_add(ctr, 1u, __ATOMIC_RELAXED, __HIP_MEMORY_SCOPE_AGENT);
        __syncthreads();
        const int unit = ubox[0];
        __syncthreads();
        if (unit >= M / 64) break;
        const int row0 = unit * 64, t0 = row0 & (SEQ - 1);
        const bf16* Up = U + (size_t)row0 * 1024 + c0; bf16* Gp = GC + (size_t)row0 * 1024 + c0; bf16* Op = (bf16*)(ws + out_off) + (size_t)row0 * 1024 + c0;
        f32x2 win[38];
#pragma unroll
        for (int i = 0; i < 30; ++i) { const unsigned raw = (t0 - 30 + i >= 0) ? *(const unsigned*)(Up + (long)(i - 30) * 1024) : 0u; win[i] = unpk(raw); }
        unsigned nx[8], nx2[8], gcn[8];
#pragma unroll
        for (int i = 0; i < 8; ++i) nx[i] = *(const unsigned*)(Up + (long)i * 1024);
#pragma unroll
        for (int i = 0; i < 8; ++i) nx2[i] = *(const unsigned*)(Up + (long)(8 + i) * 1024);
#pragma unroll
        for (int i = 0; i < 8; ++i) gcn[i] = *(const unsigned*)(Gp + (long)i * 1024);
#pragma unroll 1
        for (int ch = 0; ch < 8; ++ch) {
            unsigned gcr[8];
#pragma unroll
            for (int i = 0; i < 8; ++i) { win[30 + i] = unpk(nx[i]); nx[i] = nx2[i]; gcr[i] = gcn[i]; }
            { const int c2 = (ch + 2 < 8) ? ch + 2 : 7, c1 = (ch + 1 < 8) ? ch + 1 : 7;
#pragma unroll
              for (int i = 0; i < 8; ++i) nx2[i] = *(const unsigned*)(Up + (long)(c2 * 8 + i) * 1024);
#pragma unroll
              for (int i = 0; i < 8; ++i) gcn[i] = *(const unsigned*)(Gp + (long)(c1 * 8 + i) * 1024); }
            f32x2 y[8];
#pragma unroll
            for (int i = 0; i < 8; ++i) { f32x2 a = cb;
#pragma unroll
                for (int j = 0; j < CK; ++j) a += w[j] * win[i + j];
                y[i] = a; }
            float st[16];
#pragma unroll
            for (int i = 0; i < 8; ++i) { st[2 * i] = y[i].x + y[i].y; st[2 * i + 1] = y[i].x * y[i].x + y[i].y * y[i].y; }
            {
#pragma unroll
              for (int k = 0; k < 8; ++k) { const auto r = __builtin_amdgcn_permlane32_swap(__float_as_uint(st[k]), __float_as_uint(st[k + 8]), false, false); st[k] = __uint_as_float(r[0]) + __uint_as_float(r[1]); }
#pragma unroll
              for (int k = 0; k < 4; ++k) { const auto r = __builtin_amdgcn_permlane16_swap(__float_as_uint(st[k]), __float_as_uint(st[k + 4]), false, false); st[k] = __uint_as_float(r[0]) + __uint_as_float(r[1]); }
              const bool h3 = (lane & 8) != 0;
#pragma unroll
              for (int k = 0; k < 2; ++k) { const float send = h3 ? st[k] : st[k + 2], keep = h3 ? st[k + 2] : st[k]; st[k] = keep + __shfl_xor(send, 8); }
              const bool h2 = (lane & 4) != 0;
              { const float send = h2 ? st[0] : st[1], keep = h2 ? st[1] : st[0]; st[0] = keep + __shfl_xor(send, 4); }
              st[0] += __shfl_xor(st[0], 2); st[0] += __shfl_xor(st[0], 1); }
            const int pb = ch & 1;
            if ((lane & 3) == 0) red[(pb * 8 + wave) * 16 + ((lane >> 2) & 15)] = st[0];
            __syncthreads();
            if (tid < 8) { float s1 = 0.f, s2 = 0.f;
#pragma unroll
                for (int wv = 0; wv < 8; ++wv) { s1 += red[(pb * 8 + wv) * 16 + 2 * tid]; s2 += red[(pb * 8 + wv) * 16 + 2 * tid + 1]; }
                const float mu = s1 * (1.f / 1024.f), var = fmaxf(s2 * (1.f / 1024.f) - mu * mu, 0.f);
                fin[pb * 8 + tid] = (f32x2){mu, 1.0f / sqrtf(var + pg8::kEPS)}; }
            __syncthreads();
#pragma unroll
            for (int i = 0; i < 8; ++i) { const f32x2 ms = fin[pb * 8 + i]; const f32x2 a = lg * ms.y, b = lb - a * ms.x; const f32x2 z = y[i] * a + b; const f32x2 gg = unpk(gcr[i]);
                const f32x2 t = z * (-pg8::kLOG2E); f32x2 d; d.x = __builtin_amdgcn_exp2f(t.x); d.y = __builtin_amdgcn_exp2f(t.y); d = d + 1.0f;
                f32x2 r; r.x = __builtin_amdgcn_rcpf(d.x); r.y = __builtin_amdgcn_rcpf(d.y);
                const f32x2 o = (z * r) * gg;
                *(unsigned*)(Op + (long)(ch * 8 + i) * 1024) = pg8::cvt_pk_bf16(o.x, o.y); }
#pragma unroll
            for (int i = 0; i < 30; ++i) asm("v_pk_mov_b32 %0, %1, %1 op_sel:[0,1]" : "=v"(win[i]) : "v"(win[i + 8]));
        }
    }
    __syncthreads();
}

__device__ __forceinline__ void build_bias_table(const float* LF, const float* gq, const float* gk, int bh, LAS unsigned char* lds, int tid, int wave, int lane) {
    LAS v4u* tab = (LAS v4u*)(lds + BT_OFF); LAS float* wtot = (LAS float*)(lds + WT_OFF); LAS float* te = (LAS float*)(lds + WT_OFF + 256);
    const int b = bh >> 4, h = bh & 15;
    const float* lf = LF + (size_t)b * SEQ * 16 + h;
    const int t0 = 4 * tid; float v[4];
#pragma unroll
    for (int i = 0; i < 4; ++i) v[i] = lf[(size_t)(t0 + i) * 16];
    v[1] += v[0]; v[2] += v[1]; v[3] += v[2];
    const float tot = v[3]; float inc = tot;
#pragma unroll
    for (int o = 1; o < 64; o <<= 1) { const float n = __shfl_up(inc, o); if (lane >= o) inc += n; }
    if (lane == 63) wtot[wave] = inc;
    __syncthreads();
    float off = inc - tot;
    for (int wv = 0; wv < wave; ++wv) off += wtot[wv];
#pragma unroll
    for (int i = 0; i < 4; ++i) { const float bias = -(v[i] + off) * pg8::kLOG2E;
        const unsigned b1 = f2bf(bias); const float r1 = bias - __uint_as_float(b1 << 16);
        const unsigned b2 = f2bf(r1);   const float r2 = r1 - __uint_as_float(b2 << 16);
        const unsigned b3 = f2bf(r2);
        tab[t0 + i] = (v4u){b1 | (b2 << 16), b3 | 0x3F800000u, 0x3F803F80u, 0u};
        if (i == 3 && (tid & 15) == 15) te[tid >> 4] = bias; }
    if (wave == 0) { float mq = fabsf(gq[h * 64 + lane]), mk = fabsf(gk[h * 64 + lane]);
#pragma unroll
        for (int o = 1; o < 64; o <<= 1) { mq = fmaxf(mq, __shfl_xor(mq, o)); mk = fmaxf(mk, __shfl_xor(mk, o)); }
        if (lane == 0) te[32] = 2.0f * (8.0f * pg8::kLOG2E * 1.03f * mq * mk) + 51.0f; }
    __syncthreads();
}
__global__ void __launch_bounds__(NWAVES * 64, 2) skel_fwd(Args args) {
    extern __shared__ __attribute__((aligned(16))) unsigned char lds_raw[];
    LAS unsigned char* lds = (LAS unsigned char*)lds_raw;
    const int G = gridDim.x, bx = blockIdx.x, vcu = (G % 8 == 0) ? (bx % 8) * (G / 8) + bx / 8 : bx;
#define PHASE_IDS() int tid = threadIdx.x; asm volatile("" : "+v"(tid)); const int lane = tid & 63, wave = __builtin_amdgcn_readfirstlane(tid >> 6); (void)lane; (void)wave
#define KARGS() ({ KArgs k_ = (KArgs)__builtin_amdgcn_kernarg_segment_ptr(); asm volatile("" : "+s"(k_)); k_; })
#if MK_N_LAUNCHES == 1
#define IN(k) true
#define GRID_BAR() xcd_barrier(bar)
#else
    const int lo = args.ph_lo, hi = args.ph_hi;
#define IN(k) (lo <= (k) && (k) < hi)
#define GRID_BAR() do {} while (0)
#endif

#if MK_N_LAUNCHES == 1
    if (threadIdx.x < 2) ((volatile LAS unsigned*)(lds + MISC_OFF))[threadIdx.x] = 0u;
    __syncthreads();
    XcdBarrier bar = xcd_barrier_post((unsigned*)(KARGS()->ws + WS_CTL), (volatile LAS unsigned*)(lds + MISC_OFF));
    if (KARGS()->ph_lo < 0) cg::this_grid().sync();
#endif
    if (IN(0)) { PHASE_IDS(); int nrep0 = (MK_PROBE == 1) ? 2 : 1; asm volatile("" : "+s"(nrep0));
#pragma unroll 1
        for (int r = 0; r < nrep0; ++r) { p0_prologue(KARGS(), lds, vcu, G, tid, wave, lane); __syncthreads(); }

 if (IN(1)) GRID_BAR(); }

    if (IN(1)) {
        KArgs Ap = KARGS(); unsigned char* ws = Ap->ws;
        pg8::Gemm g{(const bf16*)(ws + WS_XN), (const bf16*)(ws + WS_BT1), M, N1, DMODEL, DMODEL, 1 << 30, 0l}; pg8::StaticOrder S; S.init(M, N1, G, bx);
        pg8::Epi1 E{(bf16*)(ws + WS_Q), (const float*)(ws + WS_RS), Ap->in[4], Ap->in[5], lds + ESTG_OFF};
        int nrep1 = (MK_PROBE == 2) ? 2 : 1; asm volatile("" : "+s"(nrep1));
#pragma unroll 1
        for (int r = 0; r < nrep1; ++r) { pg8::gemm_phase<pg8::Epi1, pg8::StaticOrder, true, true>(lds, g, S, E); __syncthreads(); }
#if MK_N_LAUNCHES == 1
        { PHASE_IDS(); build_bias_table((const float*)(ws + WS_LF), Ap->in[4], Ap->in[5], (G == BATCH * NH) ? (vcu & ~15) + ((vcu & 15) >> 1) : vcu % (BATCH * NH), lds, tid, wave, lane); }
#endif
        if (IN(2)) GRID_BAR();
    }

    if (IN(2)) {
        { PHASE_IDS();
        unsigned char* ws = KARGS()->ws;
        const attn_body::bf16* QB = (const attn_body::bf16*)(ws + WS_Q);
        int cur_bh = (MK_N_LAUNCHES == 1) ? ((G == BATCH * NH) ? (vcu & ~15) + ((vcu & 15) >> 1) : vcu % (BATCH * NH)) : -1;
        int pass0 = (MK_PROBE == 4) ? 0 : 1; asm volatile("" : "+s"(pass0));
#pragma unroll 1
        for (int pass = pass0; pass < 2; ++pass)
        for (int ui = 0; (G == BATCH * NH) ? ui < SEQ / 256 : vcu + ui * G < BATCH * NH * (SEQ / 256); ++ui) {
            int bh, qb;
            if (G == BATCH * NH) { const int j = (vcu & 15) >> 1, sx = vcu & 1, grp = ui >> 2, set = grp ? 1 - sx : sx, k4 = 4 * (ui & 3);
                qb = ((set ? 0x6521 : 0x7430) >> k4) & 15; bh = (vcu & ~15) + (grp ? 15 - j : j); }
            else { const int L = vcu + ui * G; bh = L % (BATCH * NH); qb = L / (BATCH * NH); }
            if (bh != cur_bh) { KArgs Aq = KARGS(); build_bias_table((const float*)(ws + WS_LF), Aq->in[4], Aq->in[5], bh, lds, tid, wave, lane); cur_bh = bh; }
            int ts = 0;
            if (qb > 0) { const LAS float* te = (const LAS float*)(lds + WT_OFF + 256); const float ref = te[4 * qb - 1], th = te[32];
                const bool c = lane < 32 && lane < 4 * qb && (ref - te[lane & 31] > th); ts = (int)__popcll(__ballot(c)) & ~1; }
            ts = __builtin_amdgcn_readfirstlane(ts);
#ifndef NO_ATTN
            attn_body::attn_unit<96>(bh >> 4, bh & 15, qb, ts, QB, QB + pg8::Epi1::ZS, QB + 2 * pg8::Epi1::ZS, pass ? (attn_body::bf16*)QB : (attn_body::bf16*)(ws + WS_XN), QB + 3 * pg8::Epi1::ZS, (char*)lds_raw, (attn_body::lds_cptr)(lds + BT_OFF));
#endif
        }
        }
        __syncthreads();
#ifndef NO_CONV
        { PHASE_IDS(); conv_phase(KARGS(), lds, vcu, G, tid, wave, lane, WS_GC); }
#endif
        if (IN(3)) GRID_BAR();
    }

    if (IN(3)) {
        KArgs Ap = KARGS(); unsigned char* ws = Ap->ws;
        pg8::Gemm g{(const bf16*)(ws + WS_Q), (const bf16*)(ws + WS_BT2), M, DMODEL, K2, DMODEL, 16, (long)(WS_GC - WS_Q) - 16l * 128l}; pg8::StaticOrder S; S.init(M, DMODEL, G, bx);
        pg8::Epi2 E{Ap->in[0], Ap->out, lds + ESTG_OFF};
        int nrep3 = (MK_PROBE == 5) ? 2 : 1; asm volatile("" : "+s"(nrep3));
#pragma unroll 1
        for (int r = 0; r < nrep3; ++r) { pg8::gemm_phase<pg8::Epi2, pg8::StaticOrder, true, true>(lds, g, S, E); __syncthreads(); }
    }
#undef KARGS
#undef IN
}

extern "C" void kernel_launch(void* const* d_in, const int* in_sizes, int n_in, void* d_out, int out_size, void* d_ws, size_t ws_size, hipStream_t stream) {
    static int grid = 0;
    if (grid == 0) {
        if (n_in != 11 || in_sizes[0] != M * DMODEL || out_size != M * DMODEL || ws_size < WS_END) { fprintf(stderr, "kernel_launch: shape/workspace mismatch (n_in %d, in0 %d, out %d, ws %zu)\n", n_in, n_in > 0 ? in_sizes[0] : -1, out_size, ws_size); grid = -1; return; }
        int dev = 0, cus = 0, per_cu = 0;
        if (hipGetDevice(&dev) != hipSuccess || hipDeviceGetAttribute(&cus, hipDeviceAttributeMultiprocessorCount, dev) != hipSuccess) { grid = -1; return; }
        if (hipFuncSetAttribute((const void*)skel_fwd, hipFuncAttributeMaxDynamicSharedMemorySize, LDS_BYTES) != hipSuccess) { fprintf(stderr, "kernel_launch: hipFuncSetAttribute failed\n"); grid = -1; return; }
        if (hipOccupancyMaxActiveBlocksPerMultiprocessor(&per_cu, (const void*)skel_fwd, NWAVES * 64, LDS_BYTES) != hipSuccess || per_cu < 1) { fprintf(stderr, "kernel_launch: occupancy query says %d blocks per CU\n", per_cu); per_cu = 1; }
        (void)hipGetLastError();
        grid = cus;
    }
    if (grid < 0) return;
    if (hipMemsetAsync((char*)d_ws + WS_CTL, 0, CTL_ZERO_BYTES, stream) != hipSuccess) { fprintf(stderr, "kernel_launch: hipMemsetAsync failed\n"); return; }
    Args a{};
    for (int i = 0; i < 11; ++i) a.in[i] = (const float*)d_in[i];
    a.out = (float*)d_out; a.ws = (unsigned char*)d_ws;
#if MK_N_LAUNCHES == 1
    a.ph_lo = 0; a.ph_hi = 4;
    void* kargs[] = {&a};
    hipError_t e = hipLaunchCooperativeKernel((const void*)skel_fwd, dim3(grid), dim3(NWAVES * 64), kargs, LDS_BYTES, stream);
    if (e != hipSuccess) fprintf(stderr, "cooperative launch failed: %s (grid %d)\n", hipGetErrorString(e), grid);
#else
    for (int p = 0; p < 4; ++p) { a.ph_lo = p; a.ph_hi = p + 1; hipLaunchKernelGGL(skel_fwd, dim3(grid), dim3(NWAVES * 64), LDS_BYTES, stream, a); }
#endif
}
```

```cpp
#include <hip/hip_runtime.h>
#include <hip/hip_cooperative_groups.h>
#include <cstdio>
#include <cstdint>
namespace cg = cooperative_groups;
#ifndef MK_PROBE
#define MK_PROBE 0
#endif
#ifndef MK_N_LAUNCHES
#define MK_N_LAUNCHES 1
#endif
namespace pg8 {
#define PG8_LAS __attribute__((address_space(3)))
typedef unsigned short bf16_t;
typedef short bf16x8 __attribute__((ext_vector_type(8)));
typedef float f32x4 __attribute__((ext_vector_type(4)));
typedef unsigned u32x4 __attribute__((ext_vector_type(4)));
constexpr int BM = 256, BK = 64, HALF = 128, HTB = HALF * BK * 2  , STAGE_BYTES = 8 * HTB, NXCD = 8, WGM = 2;

__host__ __device__ __forceinline__ int lds_byte(int r, int c) { const int st = (r >> 4) * 2 + (c >> 5), rr = r & 15, cc = c & 31, ob = rr * 64 + cc * 2; return st * 1024 + (ob ^ (((ob >> 9) & 1) << 5)); }
__host__ __device__ __forceinline__ void stage_rc(int b, int& R, int& C) { const int st = b / 1024, sb = b % 1024, swz = sb ^ (((sb >> 9) & 1) << 5); R = (st >> 1) * 16 + swz / 64; C = (st & 1) * 32 + (swz % 64) / 2; }
__host__ __device__ __forceinline__ int perm32(int rho) { const int n = rho >> 4, i = rho & 15; return 8 * (i >> 2) + 4 * n + (i & 3); }

struct Unit { int pm, pn; };
struct Gemm { const bf16_t* A; const bf16_t* Bt; int M, N, K; int lda; int ksplit; long ajump; };

struct StaticOrder {
    int nM, nN, nwg, G, c;
    __host__ __device__ void init(int M, int N, int G_, int c_) { nM = M / BM; nN = N / BM; nwg = nM * nN; G = G_; c = c_; }
    __host__ __device__ bool next(int i, Unit& u) const {
        const long L = (long)i * G + c; if (L >= nwg) return false;
        int wgid = (int)L; { const int q = nwg / NXCD, r = nwg % NXCD, xcd = wgid % NXCD, off = wgid / NXCD; wgid = (xcd < r ? xcd * (q + 1) : r * (q + 1) + (xcd - r) * q) + off; }
        const int nig = WGM * nN, gid = wgid / nig, fm = gid * WGM, gsz = (nM - fm) < WGM ? (nM - fm) : WGM;
        u.pm = fm + ((wgid % nig) % gsz); u.pn = (wgid % nig) / gsz; return true;
    }
    __device__ __forceinline__ void a_ready(const Unit&) const {}
    __device__ __forceinline__ void done(const Unit&) const {}
};
typedef __bf16 bf16x2v __attribute__((ext_vector_type(2)));
typedef float f32x2 __attribute__((ext_vector_type(2)));
__device__ __forceinline__ unsigned cvt_pk_bf16(float lo, float hi) { const f32x2 v = {lo, hi}; return __builtin_bit_cast(unsigned, __builtin_convertvector(v, bf16x2v)); }
constexpr float kEPS = 1e-6f, kLOG2E = 1.4426950408889634f, kC2 = 0.125f * 1.4426950408889634f;
__device__ __forceinline__ float sigmoid_f(float x) { return __builtin_amdgcn_rcpf(1.0f + __builtin_amdgcn_exp2f(-kLOG2E * x)); }
__device__ __forceinline__ f32x4 sigmoid4(f32x4 x) { const f32x4 t = x * (-kLOG2E); f32x4 e; e[0] = __builtin_amdgcn_exp2f(t[0]); e[1] = __builtin_amdgcn_exp2f(t[1]); e[2] = __builtin_amdgcn_exp2f(t[2]); e[3] = __builtin_amdgcn_exp2f(t[3]);
    e = e + 1.0f; f32x4 r; r[0] = __builtin_amdgcn_rcpf(e[0]); r[1] = __builtin_amdgcn_rcpf(e[1]); r[2] = __builtin_amdgcn_rcpf(e[2]); r[3] = __builtin_amdgcn_rcpf(e[3]); return r; }
__device__ __forceinline__ u32x4 pack8(f32x4 v0, f32x4 v1) { u32x4 w; w.x = cvt_pk_bf16(v0[0], v0[1]); w.y = cvt_pk_bf16(v0[2], v0[3]); w.z = cvt_pk_bf16(v1[0], v1[1]); w.w = cvt_pk_bf16(v1[2], v1[3]); return w; }
struct Epi1 {
    static constexpr bool PERM = true, AFTER_DRAIN = false;
    bf16_t* Z; const float* RS; const float *qg, *kg; PG8_LAS unsigned char* stg;
    static constexpr size_t ZS = (size_t)32 << 20;
    __device__ __forceinline__ void operator()(const f32x4 (&acc)[2][2][4][2], const Unit& u, int wr, int wc, int fr, int fq) const {
        const int pn = u.pn; const int row0 = u.pm * BM + wr * 64 + fr;
        float rsv[2][4];
#pragma unroll
        for (int ai = 0; ai < 2; ++ai)
#pragma unroll
            for (int m = 0; m < 4; ++m) rsv[ai][m] = RS[row0 + ai * HALF + m * 16];
        const int l_ = fr + 16 * fq, rr_ = l_ >> 3, cc_ = l_ & 7;
        PG8_LAS unsigned char* slab = stg + (wr * 4 + wc) * 2304;
        PG8_LAS u32x4* wp = (PG8_LAS u32x4*)(slab + fr * 144 + fq * 16); const PG8_LAS u32x4* rp = (const PG8_LAS u32x4*)(slab + rr_ * 144 + cc_ * 16);
        const size_t rowst = (size_t)(u.pm * BM + wr * 64 + rr_) * 1024;
#define EPI1_STORE128(basep, colw, AI, MM, W0, W1) do { wp[0] = (W0); wp[4] = (W1); asm volatile("s_waitcnt lgkmcnt(0)" ::: "memory"); const u32x4 a_ = rp[0], b_ = rp[72]; asm volatile("s_waitcnt lgkmcnt(0)" ::: "memory"); \
            bf16_t* d_ = (basep) + rowst + (size_t)((AI) * HALF + (MM) * 16) * 1024 + (colw) + 8 * cc_; *(u32x4*)d_ = a_; *(u32x4*)(d_ + 8 * 1024) = b_; } while (0)
        if (pn < 8) {
            const bool isq = pn < 4; const int sec = isq ? pn : pn - 4;
            bf16_t* base = Z + (isq ? 0 : ZS); const float* gp = (isq ? qg : kg) + (sec * 4 + wc) * 64 + 8 * fq; const float sc = isq ? kC2 : 1.0f;
            f32x4 g[2][2];
#pragma unroll
            for (int bj = 0; bj < 2; ++bj)
#pragma unroll
                for (int n = 0; n < 2; ++n) g[bj][n] = *(const f32x4*)(gp + 32 * bj + 4 * n) * sc;
#pragma unroll
            for (int ai = 0; ai < 2; ++ai)
#pragma unroll
                for (int m = 0; m < 4; ++m) {
                    float ss = 0.f;
#pragma unroll
                    for (int bj = 0; bj < 2; ++bj)
#pragma unroll
                        for (int n = 0; n < 2; ++n) { const f32x4 x = acc[ai][bj][m][n]; ss += (x[0] * x[0] + x[1] * x[1]) + (x[2] * x[2] + x[3] * x[3]); }
                    ss += __shfl_xor(ss, 16); ss += __shfl_xor(ss, 32);
                    const float rs = rsv[ai][m];
                    const float rinv = rs * __builtin_amdgcn_rsqf(ss * rs * rs * (1.0f / 64.0f) + kEPS);
                    const u32x4 w0 = pack8(acc[ai][0][m][0] * rinv * g[0][0], acc[ai][0][m][1] * rinv * g[0][1]), w1 = pack8(acc[ai][1][m][0] * rinv * g[1][0], acc[ai][1][m][1] * rinv * g[1][1]);
                    EPI1_STORE128(base, sec * 256 + wc * 64, ai, m, w0, w1);
                }
        } else if (pn < 16 || pn >= 24) {
            const bool act = pn >= 12; const int sec = pn < 12 ? pn - 8 : (pn < 16 ? pn - 12 : pn - 24);
            bf16_t* base = Z + (size_t)(pn < 12 ? 2 : (pn < 16 ? 3 : 5)) * ZS;
#pragma unroll
            for (int ai = 0; ai < 2; ++ai)
#pragma unroll
                for (int m = 0; m < 4; ++m) { const float rs = rsv[ai][m]; u32x4 w[2];
#pragma unroll
                    for (int bj = 0; bj < 2; ++bj) { f32x4 v0 = acc[ai][bj][m][0] * rs, v1 = acc[ai][bj][m][1] * rs;
                        if (act) { v0 = v0 * sigmoid4(v0); v1 = v1 * sigmoid4(v1); }
                        w[bj] = pack8(v0, v1); }
                    EPI1_STORE128(base, sec * 256 + wc * 64, ai, m, w[0], w[1]); }
        } else {
            const int r4 = l_ >> 2, c4 = l_ & 3; const PG8_LAS u32x4* rp4 = (const PG8_LAS u32x4*)(slab + r4 * 144 + c4 * 16);
            bf16_t* ub = Z + 4 * ZS + (size_t)(u.pm * BM + wr * 64 + r4) * 1024 + (pn - 16) * 128 + wc * 32 + 8 * c4;
#pragma unroll
            for (int ai = 0; ai < 2; ++ai)
#pragma unroll
                for (int m = 0; m < 4; ++m) { const float rs = rsv[ai][m]; f32x4 v0 = acc[ai][0][m][0] * rs, v1 = acc[ai][0][m][1] * rs; const f32x4 g0 = acc[ai][1][m][0] * rs, g1 = acc[ai][1][m][1] * rs;
                    v0 = v0 * sigmoid4(g0); v1 = v1 * sigmoid4(g1);
                    wp[0] = pack8(v0, v1); asm volatile("s_waitcnt lgkmcnt(0)" ::: "memory"); const u32x4 a_ = rp4[0]; asm volatile("s_waitcnt lgkmcnt(0)" ::: "memory");
                    *(u32x4*)(ub + (size_t)(ai * HALF + m * 16) * 1024) = a_; }
        }
#undef EPI1_STORE128
    }
};
struct Epi2 {
    static constexpr bool PERM = true, AFTER_DRAIN = false;
    const float* __restrict__ x; float* __restrict__ out; PG8_LAS unsigned char* stg;
    __device__ __forceinline__ void operator()(const f32x4 (&acc)[2][2][4][2], const Unit& u, int wr, int wc, int fr, int fq) const {
        const int l = fr + 16 * fq, rr = l >> 3, cc = l & 7;
        PG8_LAS unsigned char* slab = stg + (wr * 4 + wc) * 2304;
        PG8_LAS f32x4* wp = (PG8_LAS f32x4*)(slab + fr * 144 + fq * 32); const PG8_LAS f32x4* rp = (const PG8_LAS f32x4*)(slab + rr * 144 + cc * 16);
        const size_t g0 = (size_t)(u.pm * BM + wr * 64 + rr) * 1024 + u.pn * BM + wc * 32 + 4 * cc;
        const float* __restrict__ xb = x + g0; float* __restrict__ ob = out + g0;
#pragma unroll
        for (int ai = 0; ai < 2; ++ai) {
            f32x4 pre[4][2][2];
#pragma unroll
            for (int m = 0; m < 4; ++m)
#pragma unroll
                for (int bj = 0; bj < 2; ++bj)
#pragma unroll
                    for (int r = 0; r < 2; ++r) pre[m][bj][r] = *(const f32x4*)(xb + (size_t)(ai * HALF + m * 16 + 8 * r) * 1024 + bj * HALF);
            asm volatile("" ::: "memory");
#pragma unroll
            for (int m = 0; m < 4; ++m)
#pragma unroll
                for (int bj = 0; bj < 2; ++bj) {
                    wp[0] = acc[ai][bj][m][0]; wp[1] = acc[ai][bj][m][1];
                    asm volatile("s_waitcnt lgkmcnt(0)" ::: "memory");
                    const f32x4 v0 = rp[0], v1 = rp[8 * 9];
                    asm volatile("s_waitcnt lgkmcnt(0)" ::: "memory");
                    *(f32x4*)(ob + (size_t)(ai * HALF + m * 16) * 1024 + bj * HALF) = pre[m][bj][0] + v0;
                    *(f32x4*)(ob + (size_t)(ai * HALF + m * 16 + 8) * 1024 + bj * HALF) = pre[m][bj][1] + v1;
                }
            asm volatile("" ::: "memory");
        }
    }
};
template <class Epi, class Sched, bool ALIGN_EPI = false, bool SP2 = false>
__device__ __forceinline__ void gemm_phase(PG8_LAS unsigned char* lds, const Gemm g, const Sched& S, const Epi& E) {
    int tid_ = threadIdx.x; asm volatile("" : "+v"(tid_));
    const int tid = tid_, wid = __builtin_amdgcn_readfirstlane(tid >> 6), lane = tid & 63, wr = wid >> 2, wc = wid & 3, fr = lane & 15, fq = lane >> 4;
    const int K = g.K, nt = K / BK;
    unsigned voffA[2], voffB[2];
#pragma unroll
    for (int i = 0; i < 2; ++i) { int R, C; stage_rc(tid * 16 + i * 8192, R, C); const int Rb = Epi::PERM ? ((R & ~31) + perm32(R & 31)) : R;
        voffA[i] = (unsigned)(R * g.lda + C) * 2u; voffB[i] = (unsigned)(Rb * K + C) * 2u; }
    const size_t kstep = (size_t)(BK * 2);
    const size_t hstepA = (size_t)HALF * g.lda * 2, hstepB = (size_t)HALF * K * 2;
    const size_t tstepA = 2 * hstepA, tstepB = 2 * hstepB;
    const int ksplit = g.ksplit; const long ajump = g.ajump;
#define PG8_KOFF(t) ((size_t)(t) * kstep + ((t) >= ksplit ? ajump : 0l))
    const unsigned ldsw = (unsigned)wid * 1024u;
    const int aoff = lds_byte(wr * 64 + fr, fq * 8), boff = lds_byte(wc * 32 + fr, fq * 8);
#define PG8_SA(b, h) (((b) * 2 + (h)) * HTB)
#define PG8_SB(b, h) ((4 + (b) * 2 + (h)) * HTB)
#define PG8_STAGE(bufoff, gbase, voff) do { _Pragma("unroll") for (int _i = 0; _i < 2; ++_i) \
        __builtin_amdgcn_global_load_lds((const unsigned*)((const char*)(gbase) + (voff)[_i]), (PG8_LAS unsigned*)(lds + (bufoff) + ldsw + _i * 8192), 16, 0, 0); } while (0)
#define PG8_LDA(dst, b, h) do { _Pragma("unroll") for (int m = 0; m < 4; ++m) _Pragma("unroll") for (int k = 0; k < 2; ++k) dst[m][k] = *(const PG8_LAS bf16x8*)(lds + PG8_SA(b, h) + aoff + m * 2048 + k * 1024); } while (0)
#define PG8_LDB(dst, b, h) do { _Pragma("unroll") for (int n = 0; n < 2; ++n) _Pragma("unroll") for (int k = 0; k < 2; ++k) dst[n][k] = *(const PG8_LAS bf16x8*)(lds + PG8_SB(b, h) + boff + n * 2048 + k * 1024); } while (0)
#define PG8_MMA(ai, bj, At, Bt) do { __builtin_amdgcn_s_setprio(1); _Pragma("unroll") for (int m = 0; m < 4; ++m) _Pragma("unroll") for (int n = 0; n < 2; ++n) _Pragma("unroll") for (int k = 0; k < 2; ++k) \
        acc[ai][bj][m][n] = __builtin_amdgcn_mfma_f32_16x16x32_bf16(Bt[n][k], At[m][k], acc[ai][bj][m][n], 0, 0, 0); __builtin_amdgcn_s_setprio(0); } while (0)
#define PG8_WAIT_V(n) asm volatile("s_waitcnt vmcnt(" #n ")" ::: "memory")
#define PG8_WAIT_L(n) asm volatile("s_waitcnt lgkmcnt(" #n ")" ::: "memory")
#define PG8_BAR __builtin_amdgcn_s_barrier()
#define PG8_SCHED __builtin_amdgcn_sched_barrier(0)
    Unit cur, nxt; int ui = 0;
    if (!S.next(0, cur)) return;
    f32x4 acc[2][2][4][2];
#pragma unroll
    for (int a = 0; a < 2; ++a)
#pragma unroll
        for (int b = 0; b < 2; ++b)
#pragma unroll
            for (int m = 0; m < 4; ++m)
#pragma unroll
                for (int n = 0; n < 2; ++n) acc[a][b][m][n] = (f32x4){0.f, 0.f, 0.f, 0.f};
    bf16x8 At[4][2], B0[2][2], B1[2][2];
    const char* cA = (const char*)g.A + (size_t)cur.pm * tstepA; const char* cB = (const char*)g.Bt + (size_t)cur.pn * tstepB;
    S.a_ready(cur);
    if constexpr (SP2) {
        PG8_STAGE(PG8_SB(0, 0), cB, voffB); PG8_STAGE(PG8_SB(0, 1), cB + hstepB, voffB); PG8_STAGE(PG8_SA(0, 0), cA, voffA); PG8_STAGE(PG8_SA(0, 1), cA + hstepA, voffA);
        if (wr == 1) PG8_BAR;
        PG8_WAIT_V(2); PG8_BAR;
        PG8_STAGE(PG8_SB(1, 0), cB + kstep, voffB); PG8_STAGE(PG8_SA(1, 0), cA + kstep, voffA); PG8_STAGE(PG8_SB(1, 1), cB + hstepB + kstep, voffB);
        PG8_WAIT_V(6); PG8_BAR;
    } else {
        PG8_STAGE(PG8_SB(0, 0), cB, voffB); PG8_STAGE(PG8_SA(0, 0), cA, voffA); PG8_STAGE(PG8_SB(0, 1), cB + hstepB, voffB); PG8_STAGE(PG8_SA(0, 1), cA + hstepA, voffA);
        if (wr == 1) PG8_BAR;
        PG8_WAIT_V(4); PG8_BAR;
        PG8_STAGE(PG8_SB(1, 0), cB + kstep, voffB); PG8_STAGE(PG8_SA(1, 0), cA + kstep, voffA); PG8_STAGE(PG8_SB(1, 1), cB + hstepB + kstep, voffB);
        PG8_WAIT_V(6); PG8_BAR;
    }
    for (;;) {
        const bool has_next = S.next(ui + 1, nxt);
        const char* nA = has_next ? (const char*)g.A + (size_t)nxt.pm * tstepA : cA; const char* nB = has_next ? (const char*)g.Bt + (size_t)nxt.pn * tstepB : cB;
        for (int t = 0; t < nt; t += 2) {
            const bool last = (t == nt - 2);
            const char* a1 = cA + PG8_KOFF(t + 1);
            const char* a2 = last ? nA : cA + PG8_KOFF(t + 2); const char* b2 = last ? nB : cB + (size_t)(t + 2) * kstep;
            const char* a3 = a2 + kstep; const char* b3 = b2 + kstep;
            if (last && has_next) S.a_ready(nxt);
            if constexpr (SP2) {
            PG8_LDB(B0, 0, 0); PG8_LDB(B1, 0, 1); PG8_SCHED; PG8_LDA(At, 0, 0); PG8_STAGE(PG8_SA(1, 1), a1 + hstepA, voffA);
            PG8_WAIT_V(8); PG8_WAIT_L(0); PG8_BAR; PG8_MMA(0, 0, At, B0); PG8_MMA(0, 1, At, B1); PG8_BAR; PG8_SCHED;
            PG8_LDA(At, 0, 1); PG8_STAGE(PG8_SB(0, 0), b2, voffB); PG8_STAGE(PG8_SB(0, 1), b2 + hstepB, voffB); PG8_STAGE(PG8_SA(0, 0), a2, voffA);
            PG8_WAIT_V(8); PG8_WAIT_L(0); PG8_BAR; PG8_MMA(1, 0, At, B0); PG8_MMA(1, 1, At, B1); PG8_BAR; PG8_SCHED;
            PG8_LDB(B0, 1, 0); PG8_LDB(B1, 1, 1); PG8_SCHED; PG8_LDA(At, 1, 0); PG8_STAGE(PG8_SA(0, 1), a2 + hstepA, voffA);
            PG8_WAIT_V(8); PG8_WAIT_L(0); PG8_BAR; PG8_MMA(0, 0, At, B0); PG8_MMA(0, 1, At, B1); PG8_BAR; PG8_SCHED;
            PG8_LDA(At, 1, 1); PG8_STAGE(PG8_SB(1, 0), b3, voffB); PG8_STAGE(PG8_SB(1, 1), b3 + hstepB, voffB); PG8_STAGE(PG8_SA(1, 0), a3, voffA);
            PG8_WAIT_V(8); PG8_WAIT_L(0); PG8_BAR; PG8_MMA(1, 0, At, B0); PG8_MMA(1, 1, At, B1); PG8_BAR; PG8_SCHED;
            } else {
            PG8_LDB(B0, 0, 0); PG8_SCHED; PG8_LDA(At, 0, 0); PG8_STAGE(PG8_SA(1, 1), a1 + hstepA, voffA);
            PG8_WAIT_L(8); PG8_BAR; PG8_WAIT_L(0); PG8_MMA(0, 0, At, B0); PG8_BAR; PG8_SCHED;
            PG8_LDB(B1, 0, 1); PG8_STAGE(PG8_SB(0, 0), b2, voffB);
            PG8_BAR; PG8_WAIT_L(0); PG8_MMA(0, 1, At, B1); PG8_BAR;
            PG8_LDA(At, 0, 1); PG8_STAGE(PG8_SA(0, 0), a2, voffA);
            PG8_BAR; PG8_WAIT_L(0); PG8_MMA(1, 0, At, B0); PG8_BAR; PG8_SCHED;
            PG8_STAGE(PG8_SB(0, 1), b2 + hstepB, voffB);
            PG8_WAIT_V(6); PG8_BAR; PG8_MMA(1, 1, At, B1); PG8_BAR;
            PG8_LDB(B0, 1, 0); PG8_SCHED; PG8_LDA(At, 1, 0); PG8_STAGE(PG8_SA(0, 1), a2 + hstepA, voffA);
            PG8_WAIT_L(8); PG8_BAR; PG8_WAIT_L(0); PG8_MMA(0, 0, At, B0); PG8_BAR; PG8_SCHED;
            PG8_LDB(B1, 1, 1); PG8_STAGE(PG8_SB(1, 0), b3, voffB);
            PG8_BAR; PG8_WAIT_L(0); PG8_MMA(0, 1, At, B1); PG8_BAR;
            PG8_LDA(At, 1, 1); PG8_STAGE(PG8_SA(1, 0), a3, voffA);
            PG8_BAR; PG8_WAIT_L(0); PG8_MMA(1, 0, At, B0); PG8_BAR; PG8_SCHED;
            PG8_STAGE(PG8_SB(1, 1), b3 + hstepB, voffB);
            PG8_WAIT_V(6); PG8_BAR; PG8_MMA(1, 1, At, B1); PG8_BAR;
            }
        }
        if constexpr (ALIGN_EPI) { if (wr == 0) PG8_BAR; }
        if constexpr (!Epi::AFTER_DRAIN) { E(acc, cur, wr, wc, fr, fq); S.done(cur); }
        if (!has_next) break;
#pragma unroll
        for (int a = 0; a < 2; ++a)
#pragma unroll
            for (int b = 0; b < 2; ++b)
#pragma unroll
                for (int m = 0; m < 4; ++m)
#pragma unroll
                    for (int n = 0; n < 2; ++n) acc[a][b][m][n] = (f32x4){0.f, 0.f, 0.f, 0.f};
        cur = nxt; cA = nA; cB = nB; ++ui;
        if constexpr (ALIGN_EPI) { if (wr == 1) PG8_BAR; }
    }
    PG8_WAIT_V(0);
    if constexpr (!ALIGN_EPI) { if (wr == 0) PG8_BAR; }
    PG8_BAR;
    if constexpr (Epi::AFTER_DRAIN) { E.fused(acc, cur, wr, wc, fr, fq, lds, wid, lane); S.done(cur); }
#undef PG8_SA
#undef PG8_KOFF
#undef PG8_SB
#undef PG8_STAGE
#undef PG8_LDA
#undef PG8_LDB
#undef PG8_MMA
#undef PG8_WAIT_V
#undef PG8_WAIT_L
#undef PG8_BAR
#undef PG8_SCHED
}
}
#include <hip/hip_bf16.h>
#include <cmath>
namespace attn_body {
using bf16=__hip_bfloat16;
using bf16x8=__attribute__((ext_vector_type(8)))short;
using s16x4=__attribute__((ext_vector_type(4)))short;
using f32x16=__attribute__((ext_vector_type(16)))float;
using u32x4=__attribute__((ext_vector_type(4)))unsigned;
constexpr int BATCH=16,NHEAD=16,SEQ=2048,D=64,DM=NHEAD*D;
constexpr int NW=8,QBLK=32,QB=QBLK*NW,KVBLK=64,NQB=SEQ/QB;
constexpr int ATTN_PITCH=DM, ATTN_UNIT_ROWS=QB;
__device__ __forceinline__ int crow(int r,int hi){return (r&3)+8*(r>>2)+4*hi;}
#define SBAR() __builtin_amdgcn_sched_barrier(0)
__device__ __forceinline__ void cmask(f32x16&p0,f32x16&p1,int jb,int qrel,int hi){
  const float NEG=-INFINITY; int kb=64*jb+4*hi;
  #pragma unroll
  for(int r=0;r<16;++r){int kv=kb+(r&3)+8*(r>>2); if(kv>qrel)p0[r]=NEG; if(kv+32>qrel)p1[r]=NEG;}
}

constexpr int NSLOT=3, SLOTB=8192;
constexpr int LDS_K=0, LDS_V=NSLOT*SLOTB, LDS_WS=2*NSLOT*SLOTB, LDS_OST=LDS_WS+NW*64*4, LDS_BYTES=LDS_OST+NW*4096;
constexpr float C2=0.125f*1.4426950408889634f;
__device__ __forceinline__ void glds16(const void*gsrc,unsigned lds_dst){unsigned keep;
  asm volatile("s_mov_b32 %0, m0\n\ts_mov_b32 m0, %2\n\ts_nop 0\n\tglobal_load_lds_dwordx4 %1, off\n\ts_mov_b32 m0, %0":"=&s"(keep):"v"(gsrc),"s"(lds_dst):"memory");}
__device__ __forceinline__ float max3f(float a,float b,float c){float r;asm("v_max3_f32 %0, %1, %2, %3":"=v"(r):"v"(a),"v"(b),"v"(c));return r;}
__device__ __forceinline__ float max2f(float a,float b){float r;asm("v_max_f32_e32 %0, %1, %2":"=v"(r):"v"(a),"v"(b));return r;}
__device__ __forceinline__ float fadd_s(float a,float b){float r;asm("v_add_f32_e32 %0, %1, %2":"=v"(r):"v"(a),"v"(b));return r;}
__device__ __forceinline__ float fsub_s(float a,float b){float r;asm("v_sub_f32_e32 %0, %1, %2":"=v"(r):"v"(a),"v"(b));return r;}
typedef float f32x2_t __attribute__((ext_vector_type(2))); typedef __bf16 bf16x2_t __attribute__((ext_vector_type(2)));
__device__ __forceinline__ unsigned cvtpk_s(float lo,float hi){f32x2_t v={lo,hi};bf16x2_t b=__builtin_convertvector(v,bf16x2_t);return __builtin_bit_cast(unsigned,b);}
#define WAIT_BAR(N) asm volatile("s_waitcnt vmcnt(" #N ") lgkmcnt(0)\n\ts_barrier":::"memory")

__device__ __forceinline__ void qkt(f32x16&p0,f32x16&p1,const char*Kslot,const bf16x8*qr,int r32,int hi,s16x4 ka0,s16x4 ka1,s16x4 qaug){
  const f32x16 zero=f32x16{};
  const char*kb=Kslot+hi*1024+r32*16;
  #pragma unroll
  for(int d0=0;d0<4;++d0){
    const bf16x8 b0=*reinterpret_cast<const bf16x8*>(kb+d0*2048);
    const bf16x8 b1=*reinterpret_cast<const bf16x8*>(kb+d0*2048+512);
    if(d0==0){p0=__builtin_amdgcn_mfma_f32_32x32x16_bf16(b0,qr[0],zero,0,0,0);p1=__builtin_amdgcn_mfma_f32_32x32x16_bf16(b1,qr[0],zero,0,0,0);}
    else{p0=__builtin_amdgcn_mfma_f32_32x32x16_bf16(b0,qr[d0],p0,0,0,0);p1=__builtin_amdgcn_mfma_f32_32x32x16_bf16(b1,qr[d0],p1,0,0,0);}}
  p0=__builtin_amdgcn_mfma_f32_32x32x8bf16_1k(ka0,qaug,p0,0,0,0);p1=__builtin_amdgcn_mfma_f32_32x32x8bf16_1k(ka1,qaug,p1,0,0,0);
}
typedef __attribute__((address_space(3))) const char* lds_cptr;
typedef short v4i16_t __attribute__((ext_vector_type(4)));
__device__ __forceinline__ void kload8(bf16x8*kf,lds_cptr kp){
  kf[0]=*(const __attribute__((address_space(3))) bf16x8*)(kp);      kf[1]=*(const __attribute__((address_space(3))) bf16x8*)(kp+512);
  kf[2]=*(const __attribute__((address_space(3))) bf16x8*)(kp+2048); kf[3]=*(const __attribute__((address_space(3))) bf16x8*)(kp+2560);
  kf[4]=*(const __attribute__((address_space(3))) bf16x8*)(kp+4096); kf[5]=*(const __attribute__((address_space(3))) bf16x8*)(kp+4608);
  kf[6]=*(const __attribute__((address_space(3))) bf16x8*)(kp+6144); kf[7]=*(const __attribute__((address_space(3))) bf16x8*)(kp+6656);
}
__device__ __forceinline__ void kload2(bf16x8*kf,lds_cptr kp,int j){ kf[2*j]=*(const __attribute__((address_space(3))) bf16x8*)(kp+j*2048); kf[2*j+1]=*(const __attribute__((address_space(3))) bf16x8*)(kp+j*2048+512); }
__device__ __forceinline__ s16x4 vtr(lds_cptr p){ return __builtin_bit_cast(s16x4,__builtin_amdgcn_ds_read_tr16_b64_v4i16((__attribute__((address_space(3))) v4i16_t*)p)); }
__device__ __forceinline__ float rowmax(const f32x16&p0,const f32x16&p1){
  float a=max3f(p0[0],p0[1],p1[0]),b=max3f(p0[2],p0[3],p1[1]);a=max3f(a,p1[2],p1[3]);
  #pragma unroll
  for(int r=4;r<16;r+=4){a=max3f(a,p0[r],p0[r+1]);b=max3f(b,p0[r+2],p0[r+3]);a=max3f(a,p1[r],p1[r+1]);b=max3f(b,p1[r+2],p1[r+3]);}
  const float m=max2f(a,b);
  auto rr=__builtin_amdgcn_permlane32_swap(__float_as_uint(m),__float_as_uint(m),false,false);
  return max2f(__uint_as_float(rr[0]),__uint_as_float(rr[1]));
}
__device__ __forceinline__ void pv(f32x16*o,int vb,bf16x8 pa0,bf16x8 pa1,bf16x8 pa2,bf16x8 pa3){
  #pragma unroll
  for(int d0=0;d0<2;++d0){s16x4 lo[4],hi[4];
    #pragma unroll
    for(int ks=0;ks<4;++ks){
      asm volatile("ds_read_b64_tr_b16 %0,%1 offset:%c2":"=&v"(lo[ks]):"v"(vb),"i"(d0*4096+ks*1024):"memory");
      asm volatile("ds_read_b64_tr_b16 %0,%1 offset:%c2":"=&v"(hi[ks]):"v"(vb),"i"(d0*4096+ks*1024+512):"memory");}
    asm volatile("s_waitcnt lgkmcnt(0)":::"memory");SBAR();
    #define PK(k) (bf16x8){lo[k][0],lo[k][1],lo[k][2],lo[k][3],hi[k][0],hi[k][1],hi[k][2],hi[k][3]}
    o[d0]=__builtin_amdgcn_mfma_f32_32x32x16_bf16(pa0,PK(0),o[d0],0,0,0);
    o[d0]=__builtin_amdgcn_mfma_f32_32x32x16_bf16(pa1,PK(1),o[d0],0,0,0);
    o[d0]=__builtin_amdgcn_mfma_f32_32x32x16_bf16(pa2,PK(2),o[d0],0,0,0);
    o[d0]=__builtin_amdgcn_mfma_f32_32x32x16_bf16(pa3,PK(3),o[d0],0,0,0);
    #undef PK
  }
}

#ifndef ATTN_STORE16
#define ATTN_STORE16(p,v) (*(u32x4*)(p)=(v))
#endif
template<int THRL> __device__ __forceinline__ void attn_unit(int b,int h,int qb,int ts,const bf16*Q,const bf16*__restrict__ K,const bf16*__restrict__ V,bf16*O,const bf16*__restrict__ GF,char*shm,lds_cptr btab){
  int tid_=threadIdx.x; asm volatile("":"+v"(tid_)); const int tid=tid_,lane=tid&63,r32=lane&31,hi=lane>>5; const int wid=__builtin_amdgcn_readfirstlane(tid>>6);
  const long rowbase=(long)b*SEQ; const int q0=qb*QB;
  const bf16*Qw=Q+(rowbase+q0+wid*QBLK)*DM+h*D;
  const bf16*Kh=K+(rowbase+(long)ts*KVBLK)*DM+h*D,*Vh=V+(rowbase+(long)ts*KVBLK)*DM+h*D;
  const unsigned lds0=(unsigned)(uintptr_t)shm;
  float*wsf=(float*)(shm+LDS_WS)+wid*64;
  const bf16*ksrc=Kh+(long)lane*DM+wid*8;
  const bf16*vsrc=Vh+(long)(16*(wid&3)+(lane>>2))*DM+(wid>>2)*32+(lane&3)*8;
  const unsigned kdst=lds0+LDS_K+wid*1024, vdst=lds0+LDS_V+wid*1024;
  #define DMA_K(t,slot) glds16(ksrc+(long)(t)*KVBLK*DM,(unsigned)__builtin_amdgcn_readfirstlane(kdst+(slot)))
  #define DMA_V(t,slot) glds16(vsrc+(long)(t)*KVBLK*DM,(unsigned)__builtin_amdgcn_readfirstlane(vdst+(slot)))
  const int vb0=(int)(lds0+LDS_V)+((lane>>4)&1)*32+(lane&3)*8+(4*hi+((lane&15)>>2))*64;
  const char*Kbase=shm+LDS_K; bf16x8 kf[8];
  const lds_cptr shm3=(lds_cptr)shm; const lds_cptr kp0=shm3+LDS_K+hi*1024+r32*16; const lds_cptr vp0=shm3+LDS_V+((lane>>4)&1)*32+(lane&3)*8+(4*hi+((lane&15)>>2))*64;
  const int NT=(q0+QB)/KVBLK-ts;
  DMA_K(0,0);DMA_V(0,0);DMA_K(1,SLOTB);
  bf16x8 qr[4];
  #pragma unroll
  for(int d0=0;d0<4;++d0)qr[d0]=*reinterpret_cast<const bf16x8*>(&Qw[(long)r32*DM+d0*16+hi*8]);
  typedef unsigned u32x2_t __attribute__((ext_vector_type(2)));
  const lds_cptr bt0=btab+ts*(KVBLK*16)+r32*16+hi*8;
  #define KAUG(t,half) __builtin_bit_cast(s16x4,*(const __attribute__((address_space(3))) u32x2_t*)(bt0+((t)*64+(half)*32)*16))
  u32x2_t qaw=hi?(u32x2_t){0u,0u}:(u32x2_t){0x3F803F80u,0x00003F80u};
  #define QAUG __builtin_bit_cast(s16x4,qaw)
  #define SETQ() do{ const float nm_=-mhat; const unsigned m1_=cvtpk_s(nm_,0.f)&0xffffu; const float r1_=nm_-__uint_as_float(m1_<<16); const unsigned m2_=cvtpk_s(r1_,0.f)&0xffffu; const float r2_=r1_-__uint_as_float(m2_<<16); \
    const unsigned m3_=cvtpk_s(r2_,0.f)&0xffffu; qaw=hi?(u32x2_t){m2_|(m3_<<16),0u}:(u32x2_t){0x3F803F80u,0x3F80u|(m1_<<16)}; }while(0)
  typedef unsigned u32x2_t __attribute__((ext_vector_type(2)));
  float mhat=0.f,l_reg=0.f;f32x16 o[2];o[0]=f32x16{};o[1]=f32x16{};const f32x16 zero16=f32x16{};
  const int qrel=wid*QBLK+r32;
  #define CMASK(P0,P1,t) do{int jb_=(t)-(NT-4); if(jb_>=0)cmask(P0,P1,jb_,qrel,hi);}while(0)
  bool resc=false;
  #define START(P0,P1) do{ const float rm=rowmax(P0,P1); resc=false; \
    { const float dl=rm; mhat=fadd_s(mhat,dl); \
      _Pragma("unroll") for(int r=0;r<16;++r){P0[r]=fsub_s(P0[r],dl);P1[r]=fsub_s(P1[r],dl);} \
      SETQ(); } \
    _Pragma("unroll") for(int r=0;r<16;++r)P0[r]=__builtin_amdgcn_exp2f(P0[r]); }while(0)
  #define RESC() do{ if(resc){ asm volatile("s_waitcnt lgkmcnt(0)":::"memory"); \
      _Pragma("unroll") for(int d_=0;d_<2;++d_) _Pragma("unroll") for(int r=0;r<16;++r)o[d_][r]*=wsf[crow(r,hi)]; } }while(0)
  f32x16 pA0,pA1,pB0,pB1;
  int sl_prev=0,sl_cur=0,sl_next=SLOTB;
  #define ROT() do{sl_prev=sl_cur;sl_cur=sl_next;sl_next=(sl_next==(NSLOT-1)*SLOTB)?0:sl_next+SLOTB;}while(0)
  DMA_K(2,2*SLOTB);
  WAIT_BAR(3);
  qkt(pA0,pA1,Kbase,qr,r32,hi,KAUG(0,0),KAUG(0,1),QAUG);asm volatile("s_nop 15\n\ts_nop 7":"+v"(pA0),"+v"(pA1));CMASK(pA0,pA1,0);
  START(pA0,pA1);
  _Pragma("unroll") for(int r=0;r<16;++r)pA1[r]=__builtin_amdgcn_exp2f(pA1[r]);
  WAIT_BAR(0);
  DMA_K(3,0);DMA_V(1,SLOTB);
  ROT();
  kload8(kf,kp0+sl_cur);
  WAIT_BAR(2);
  s16x4 vlo[8],vhi[8]; u32x4 pw0,pw1,pw2,pw3;
  #define PKW(P,B) cvtpk_s(P[B],P[B+1])
  #define PAF(k) __builtin_bit_cast(bf16x8,pw##k)
  #define VFR(i) (bf16x8){vlo[i][0],vlo[i][1],vlo[i][2],vlo[i][3],vhi[i][0],vhi[i][1],vhi[i][2],vhi[i][3]}
  #define PIN(x) asm volatile("":"+v"(x))
  #define MX3(a,b,c) __builtin_fmaxf(__builtin_fmaxf((a),(b)),(c))
  #define GAPA(MF,A0,A1,A2,A3,W0,W1,PW) do{ MF; sacc+=A0; sacc+=A1; sacc+=A2; sacc+=A3; PIN(sacc); W0; W1; PIN(PW); SBAR(); }while(0)
  #define EX(v) __builtin_amdgcn_exp2f(v)
  #define GAPB(MF,X,B) do{ MF; X[B]=EX(X[B]); X[B+1]=EX(X[B+1]); X[B+2]=EX(X[B+2]); X[B+3]=EX(X[B+3]); PIN(X); SBAR(); }while(0)
  #define VRD(i) do{ vlo[i]=vtr(vp_+(((i)>>2)*4096+((i)&3)*1024)); vhi[i]=vtr(vp_+(((i)>>2)*4096+((i)&3)*1024+512)); }while(0)
  #define KRD(G,j) do{ if(G){ kload2(kf,kp0+sl_next,j); SBAR(); } }while(0)
  #define STEP(C0,C1,P0,P1,t,GK,GV,GL) do{ SBAR(); \
    const lds_cptr vp_=vp0+sl_prev; const s16x4 ka0_=KAUG(t,0),ka1_=KAUG(t,1); \
    VRD(0); SBAR(); float sacc=(P0[0]+P0[1]); \
    GAPA(C0=__builtin_amdgcn_mfma_f32_32x32x16_bf16(kf[0],qr[0],zero16,0,0,0), P0[2],P0[3],P0[4],P0[5],     pw0[0]=PKW(P0,0), pw0[1]=PKW(P0,2), pw0); \
    VRD(4); SBAR(); GAPA(C1=__builtin_amdgcn_mfma_f32_32x32x16_bf16(kf[1],qr[0],zero16,0,0,0), P0[6],P0[7],P0[8],P0[9],     pw0[2]=PKW(P0,4), pw0[3]=PKW(P0,6), pw0); \
    VRD(1); SBAR(); GAPA(C0=__builtin_amdgcn_mfma_f32_32x32x16_bf16(kf[2],qr[1],C0,0,0,0),   P0[10],P0[11],P0[12],P0[13], pw1[0]=PKW(P0,8), pw1[1]=PKW(P0,10), pw1); \
    VRD(5); SBAR(); GAPA(C1=__builtin_amdgcn_mfma_f32_32x32x16_bf16(kf[3],qr[1],C1,0,0,0),   P0[14],P0[15],P1[0],P1[1],   pw1[2]=PKW(P0,12),pw1[3]=PKW(P0,14), pw1); \
    VRD(2); SBAR(); GAPA(C0=__builtin_amdgcn_mfma_f32_32x32x16_bf16(kf[4],qr[2],C0,0,0,0),   P1[2],P1[3],P1[4],P1[5],     pw2[0]=PKW(P1,0), pw2[1]=PKW(P1,2), pw2); \
    VRD(6); SBAR(); GAPA(C1=__builtin_amdgcn_mfma_f32_32x32x16_bf16(kf[5],qr[2],C1,0,0,0),   P1[6],P1[7],P1[8],P1[9],     pw2[2]=PKW(P1,4), pw2[3]=PKW(P1,6), pw2); \
    VRD(3); SBAR(); GAPA(C0=__builtin_amdgcn_mfma_f32_32x32x16_bf16(kf[6],qr[3],C0,0,0,0),   P1[10],P1[11],P1[12],P1[13], pw3[0]=PKW(P1,8), pw3[1]=PKW(P1,10), pw3); \
    VRD(7); SBAR(); GAPA(C1=__builtin_amdgcn_mfma_f32_32x32x16_bf16(kf[7],qr[3],C1,0,0,0),   P1[14],P1[15],0.f,0.f,       pw3[2]=PKW(P1,12),pw3[3]=PKW(P1,14), pw3); \
    C0=__builtin_amdgcn_mfma_f32_32x32x8bf16_1k(ka0_,QAUG,C0,0,0,0); C1=__builtin_amdgcn_mfma_f32_32x32x8bf16_1k(ka1_,QAUG,C1,0,0,0); \
    l_reg+=sacc; \
    if(GK){DMA_K((t)+3,sl_cur);} if(GV){DMA_V((t)+1,sl_next);} \
    CMASK(C0,C1,t); \
    { float a=MX3(C0[0],C0[1],C1[0]),b=MX3(C0[2],C0[3],C1[1]); a=MX3(a,C1[2],C1[3]); \
      _Pragma("unroll") for(int r=4;r<16;r+=4){a=MX3(a,C0[r],C0[r+1]);b=MX3(b,C0[r+2],C0[r+3]);a=MX3(a,C1[r],C1[r+1]);b=MX3(b,C1[r+2],C1[r+3]);} \
      float rm=__builtin_fmaxf(a,b); { auto rr=__builtin_amdgcn_permlane32_swap(__float_as_uint(rm),__float_as_uint(rm),false,false); rm=__builtin_fmaxf(__uint_as_float(rr[0]),__uint_as_float(rr[1])); } \
      resc=false; \
      if(__builtin_expect(__any(rm>(float)THRL),0)){ const float dl=__builtin_fmaxf(rm,0.f); mhat+=dl; \
        _Pragma("unroll") for(int r=0;r<16;++r){C0[r]-=dl;C1[r]-=dl;} \
        SETQ(); \
        const float f=__builtin_amdgcn_exp2f(-dl); l_reg*=f; if(hi==0)wsf[r32]=f; resc=true; } } \
    SBAR(); \
    GAPB(o[0]=__builtin_amdgcn_mfma_f32_32x32x16_bf16(PAF(0),VFR(0),o[0],0,0,0), C0,0); \
    GAPB(o[1]=__builtin_amdgcn_mfma_f32_32x32x16_bf16(PAF(0),VFR(4),o[1],0,0,0), C0,4); \
    KRD(GL,0); GAPB(o[0]=__builtin_amdgcn_mfma_f32_32x32x16_bf16(PAF(1),VFR(1),o[0],0,0,0), C0,8); \
    KRD(GL,1); GAPB(o[1]=__builtin_amdgcn_mfma_f32_32x32x16_bf16(PAF(1),VFR(5),o[1],0,0,0), C0,12); \
    KRD(GL,2); GAPB(o[0]=__builtin_amdgcn_mfma_f32_32x32x16_bf16(PAF(2),VFR(2),o[0],0,0,0), C1,0); \
    KRD(GL,3); GAPB(o[1]=__builtin_amdgcn_mfma_f32_32x32x16_bf16(PAF(2),VFR(6),o[1],0,0,0), C1,4); \
    GAPB(o[0]=__builtin_amdgcn_mfma_f32_32x32x16_bf16(PAF(3),VFR(3),o[0],0,0,0), C1,8); \
    GAPB(o[1]=__builtin_amdgcn_mfma_f32_32x32x16_bf16(PAF(3),VFR(7),o[1],0,0,0), C1,12); \
    }while(0)
  int t=1;
  #undef CMASK
  #define CMASK(P0,P1,t) do{}while(0)
  for(;t+5<NT;t+=2){
    STEP(pB0,pB1,pA0,pA1,t,true,true,true);     WAIT_BAR(2); RESC(); ROT();
    STEP(pA0,pA1,pB0,pB1,t+1,true,true,true);   WAIT_BAR(2); RESC(); ROT();
  }
  #undef CMASK
  #define CMASK(P0,P1,t) do{int jb_=(t)-(NT-4); if(jb_>=0)cmask(P0,P1,jb_,qrel,hi);}while(0)
  #define ENDW(tt) do{ if((tt)+3<NT){WAIT_BAR(2);} else if((tt)+2<NT){WAIT_BAR(1);} else {WAIT_BAR(0);} }while(0)
  for(;t+1<NT;t+=2){
    STEP(pB0,pB1,pA0,pA1,t,(t+3<NT),(t+1<NT),(t+1<NT));       ENDW(t);   RESC(); ROT();
    STEP(pA0,pA1,pB0,pB1,t+1,(t+4<NT),(t+2<NT),(t+2<NT));     ENDW(t+1); RESC(); ROT();
  }
  #define DRAIN(P0,P1,slot) do{ float sacc=P0[0]+P0[1]; _Pragma("unroll") for(int r=2;r<16;++r)sacc+=P0[r]; _Pragma("unroll") for(int r=0;r<16;++r)sacc+=P1[r]; l_reg+=sacc; \
    pw0=(u32x4){PKW(P0,0),PKW(P0,2),PKW(P0,4),PKW(P0,6)};pw1=(u32x4){PKW(P0,8),PKW(P0,10),PKW(P0,12),PKW(P0,14)};pw2=(u32x4){PKW(P1,0),PKW(P1,2),PKW(P1,4),PKW(P1,6)};pw3=(u32x4){PKW(P1,8),PKW(P1,10),PKW(P1,12),PKW(P1,14)}; \
    SBAR(); pv(o,vb0+(slot),PAF(0),PAF(1),PAF(2),PAF(3)); }while(0)
  if(wid>=6){ STEP(pB0,pB1,pA0,pA1,NT-1,false,false,false); RESC(); DRAIN(pB0,pB1,sl_cur); }
  else if(wid>=4){ DRAIN(pA0,pA1,sl_prev); }
  #undef DRAIN
  #undef PKW
  #undef PAF
  #undef VFR
  #undef PIN
  #undef MX3
  #undef GAPA
  #undef GAPB
  #undef EX
  #undef VRD
  #undef KRD
  #undef STEP
  #undef ENDW
  {auto rr=__builtin_amdgcn_permlane32_swap(__float_as_uint(l_reg),__float_as_uint(l_reg),false,false);l_reg=__uint_as_float(rr[0])+__uint_as_float(rr[1]);}
  if(hi==0)wsf[32+r32]=l_reg;asm volatile("s_waitcnt lgkmcnt(0)":::"memory");
  float rli[16];
  #pragma unroll
  for(int r=0;r<16;++r)rli[r]=__builtin_amdgcn_rcpf(wsf[32+crow(r,hi)]);
  bf16*Ow=O+(rowbase+q0+wid*QBLK)*DM+h*D; const bf16*Gw=GF+(rowbase+q0+wid*QBLK)*DM+h*D;
  u32x4 gv[4];
  #pragma unroll
  for(int i=0;i<4;++i){const int row=i*8+(lane>>3),ch=lane&7; gv[i]=*(const u32x4*)(Gw+(long)row*DM+ch*8);}
  { bf16*stg=(bf16*)(shm+LDS_OST)+wid*2048;
    #pragma unroll
    for(int r=0;r<16;++r){const int orow=crow(r,hi);
      #pragma unroll
      for(int d0=0;d0<2;++d0)stg[orow*64+d0*32+r32]=__float2bfloat16(o[d0][r]*rli[r]);}
    asm volatile("s_waitcnt lgkmcnt(0)":::"memory");
    #pragma unroll
    for(int i=0;i<4;++i){const int row=i*8+(lane>>3),ch=lane&7; u32x4 v=*(const u32x4*)(stg+row*64+ch*8);
      #pragma unroll
      for(int j=0;j<4;++j){const unsigned a=v[j],g=gv[i][j]; v[j]=cvtpk_s(__uint_as_float(a<<16)*__uint_as_float(g<<16),__uint_as_float(a&0xffff0000u)*__uint_as_float(g&0xffff0000u));}
      ATTN_STORE16(Ow+(long)row*DM+ch*8,v);} }
  asm volatile("s_waitcnt lgkmcnt(0)\n\ts_barrier":::"memory");
  #undef DMA_K
  #undef KAUG
  #undef QAUG
  #undef SETQ
  #undef DMA_V
  #undef CMASK
  #undef START
  #undef RESC
  #undef ROT
}
constexpr int ATTN_LDS_BYTES=LDS_BYTES;
struct AttnTensors { const bf16* Q; const bf16* K; const bf16* V; bf16* O; const bf16* GF; };
#undef SBAR
#undef WAIT_BAR
}
constexpr int NWAVES = 8;
constexpr int BATCH = 16, SEQ = 2048, DMODEL = 1024, NH = 16, HD = 64, CK = 31;
constexpr int M = BATCH * SEQ;
constexpr int IN_COLS = 7184;
constexpr int O_Q = 0, O_K = 1024, O_V = 2048, O_F = 3072, O_GF = 3088, O_GLU = 4112, O_GC = 6160;
constexpr int N1 = 28 * 256;
constexpr int K2 = 2048;
constexpr size_t MiB = 1u << 20;
constexpr int CW_CONV = 3520;
constexpr size_t WS_CTL = 0, CTL_ZERO_BYTES = 16384;
constexpr size_t WS_BT1 = 2 * MiB;
constexpr size_t WS_BT2 = 18 * MiB;
constexpr size_t WS_RS = 26 * MiB;
constexpr size_t WS_LF = 24 * MiB;
constexpr size_t WS_XN = 32 * MiB;
constexpr size_t WS_Q = 96 * MiB, WS_K = 160 * MiB, WS_V = 224 * MiB, WS_GF = 288 * MiB, WS_U = 352 * MiB, WS_GC = 416 * MiB, WS_END = 480 * MiB;
constexpr int RING_BYTES = 131072;
constexpr int LDS_BYTES = 151552;
constexpr int BT_OFF = 98304, BT_BYTES = 32768, WT_OFF = BT_OFF + BT_BYTES;
constexpr int MISC_OFF = WT_OFF + 128;
constexpr int ESTG_OFF = WT_OFF + 512, ESTG_BYTES = 8 * 2304;
static_assert(ESTG_OFF + ESTG_BYTES <= LDS_BYTES, "LDS map");
static_assert(attn_body::ATTN_LDS_BYTES <= BT_OFF && MISC_OFF + 64 <= LDS_BYTES, "LDS map");

#define GAS __attribute__((address_space(1)))
#define LAS __attribute__((address_space(3)))
typedef unsigned short bf16;
typedef unsigned v4u __attribute__((ext_vector_type(4)));
typedef unsigned v2u __attribute__((ext_vector_type(2)));
typedef float f32x4 __attribute__((ext_vector_type(4)));
typedef float f32x2 __attribute__((ext_vector_type(2)));
__device__ __forceinline__ unsigned f2bf(float f) { unsigned u = __builtin_bit_cast(unsigned, f); return (u + 0x7fffu + ((u >> 16) & 1u)) >> 16; }
__device__ __forceinline__ unsigned pk2(float lo, float hi) { return f2bf(lo) | (f2bf(hi) << 16); }
__device__ __forceinline__ float bf_lo(unsigned w) { return __uint_as_float(w << 16); }
__device__ __forceinline__ float bf_hi(unsigned w) { return __uint_as_float(w & 0xffff0000u); }
__device__ __forceinline__ float wave_sum(float v) {
#pragma unroll
    for (int o = 1; o < 64; o <<= 1) v += __shfl_xor(v, o);
    return v;
}
struct Args { const float* in[11]; float* out; unsigned char* ws; int ph_lo, ph_hi; };
typedef const __attribute__((address_space(4))) Args* KArgs;

#define RLX_AGENT __ATOMIC_RELAXED, __HIP_MEMORY_SCOPE_AGENT
#define LDS_WAIT() asm volatile("s_waitcnt lgkmcnt(0)" ::: "memory")
#define VM_WAIT() asm volatile("s_waitcnt vmcnt(0)" ::: "memory")
#define XB_TMO      128
#define XB_XCNT(j)  (256  + 64 * (j))
#define XB_XSUB(j)  (1280 + 64 * (j))
#define XB_XGEN(j)  (2304 + 64 * (j))
#define XB_TOP      3328
#define XB_TOPGEN   3392
#define XCD_BAR_WORDS 3456
#define XB_SPIN_CAP (1u << 18)

__device__ __forceinline__ unsigned xb_ld(unsigned* p)              { return __hip_atomic_load(p, __ATOMIC_RELAXED, __HIP_MEMORY_SCOPE_AGENT); }
__device__ __forceinline__ unsigned xb_add(unsigned* p, unsigned v) { return __hip_atomic_fetch_add(p, v, __ATOMIC_RELAXED, __HIP_MEMORY_SCOPE_AGENT); }
__device__ __forceinline__ unsigned xb_xcc_id() { return (unsigned)__builtin_amdgcn_s_getreg((3 << 11) | 20) & 0xFu; }
#define XB_SPIN(cond, bar) do { unsigned _sp = 0; while (cond) { __builtin_amdgcn_s_sleep(1); \
    if ((++_sp & 255u) == 0u) { if (xb_ld(&(bar)[XB_TMO])) break; if (_sp > XB_SPIN_CAP) { atomicAdd(&(bar)[XB_TMO], 1u); break; } } } } while (0)

struct XcdBarrier {
    unsigned* bar; unsigned x;
    volatile LAS unsigned* st;
};

__device__ __forceinline__ XcdBarrier xcd_barrier_post(unsigned* bar, volatile LAS unsigned* st) {
    XcdBarrier b; b.bar = bar; b.x = xb_xcc_id(); b.st = st;
    if (threadIdx.x == 0) (void)xb_add(&bar[XB_XCNT(b.x)], 1u);
    return b;
}
__device__ __forceinline__ void xcd_barrier_complete(unsigned* bar, unsigned x, unsigned& nloc, unsigned& nx) {
    const unsigned G = gridDim.x * gridDim.y * gridDim.z;
    unsigned sum, cnt, mine, sp = 0u;
    for (;;) {
        sum = 0u; cnt = 0u; mine = 0u;
#pragma unroll
        for (unsigned j = 0; j < 16; ++j) { const unsigned c = xb_ld(&bar[XB_XCNT(j)]); sum += c; cnt += (c > 0u) ? 1u : 0u; mine = (j == x) ? c : mine; }
        if (sum == G) break;
        __builtin_amdgcn_s_sleep(1);
        if ((++sp & 255u) == 0u) { if (xb_ld(&bar[XB_TMO])) break; if (sp > XB_SPIN_CAP) { atomicAdd(&bar[XB_TMO], 1u); break; } }
    }
    nloc = mine > 0u ? mine : 1u; nx = cnt > 0u ? cnt : 1u;
}

__device__ __forceinline__ void xcd_barrier(const XcdBarrier& b) {
    asm volatile("s_waitcnt vmcnt(0)" ::: "memory");
    __syncthreads();
    if (threadIdx.x == 0) {
        unsigned* bar = b.bar;
        __builtin_amdgcn_s_waitcnt(0);
        unsigned nloc = b.st[0], nx = b.st[1];
        if (nloc == 0u) { xcd_barrier_complete(bar, b.x, nloc, nx); b.st[0] = nloc; b.st[1] = nx; }
        const unsigned old = xb_add(&bar[XB_XSUB(b.x)], 1u);
        const unsigned gen = old / nloc;
        if (old + 1u == (gen + 1u) * nloc) {
            __builtin_amdgcn_fence(__ATOMIC_RELEASE, "agent");
            asm volatile("s_waitcnt vmcnt(0)" ::: "memory");
            const unsigned og = xb_add(&bar[XB_TOP], 1u);
            const unsigned tg = og / nx;
            if (og + 1u == (tg + 1u) * nx) xb_add(&bar[XB_TOPGEN], 1u);
            else XB_SPIN(xb_ld(&bar[XB_TOPGEN]) == tg, bar);
            __builtin_amdgcn_fence(__ATOMIC_ACQUIRE, "agent");
            xb_add(&bar[XB_XGEN(b.x)], 1u);
            asm volatile("s_waitcnt vmcnt(0)" ::: "memory");
        } else {
            XB_SPIN(xb_ld(&bar[XB_XGEN(b.x)]) == gen, bar);
            __builtin_amdgcn_fence(__ATOMIC_ACQUIRE, "agent");
            asm volatile("s_waitcnt vmcnt(0)" ::: "memory");
        }
    }
    __syncthreads();
}

__device__ __forceinline__ void p0_transpose_item(const float* __restrict__ W, int ldw, int src_col0, const float* __restrict__ gk, bool use_g, bf16* __restrict__ WT, int K, int dst_row0, int kb, LAS float* scr, int lane) {
    const int k0 = 64 * kb, c = lane & 31, kh = lane >> 5;
    const float* __restrict__ wp = W + (size_t)(k0 + kh) * ldw + src_col0 + c; const float* __restrict__ gp = gk + ((k0 + kh) & (DMODEL - 1));
    float v[32], gg[32];
#pragma unroll
    for (int i = 0; i < 32; ++i) { v[i] = wp[(size_t)(2 * i) * ldw]; gg[i] = gp[2 * i]; }
    asm volatile("" ::: "memory");
#pragma unroll
    for (int i = 0; i < 32; ++i) scr[(2 * i + kh) * 33 + c] = v[i] * (use_g ? gg[i] : 1.0f);
    asm volatile("s_waitcnt lgkmcnt(0)" ::: "memory");
    const int c8 = lane & 7;
#pragma unroll
    for (int j = 0; j < 4; ++j) { const int n = (lane >> 3) + 8 * j; const LAS float* s = scr + (8 * c8) * 33 + n;
        v4u o; o.x = pk2(s[0 * 33], s[1 * 33]); o.y = pk2(s[2 * 33], s[3 * 33]); o.z = pk2(s[4 * 33], s[5 * 33]); o.w = pk2(s[6 * 33], s[7 * 33]);
        *(v4u*)(WT + (size_t)(dst_row0 + n) * K + k0 + 8 * c8) = o; }
    asm volatile("s_waitcnt lgkmcnt(0)" ::: "memory");
}
__device__ __forceinline__ int bt1_src(int rg) {
    const int pn = rg >> 3, tcg = rg & 7, bj = tcg >> 2, wc = tcg & 3;
    if (pn < 4)  return O_Q + 256 * pn + 64 * wc + 32 * bj;
    if (pn < 8)  return O_K + 256 * (pn - 4) + 64 * wc + 32 * bj;
    if (pn < 12) return O_V + 256 * (pn - 8) + 64 * wc + 32 * bj;
    if (pn < 16) return O_GF + 256 * (pn - 12) + 64 * wc + 32 * bj;
    if (pn < 24) return O_GLU + 1024 * bj + 128 * (pn - 16) + 32 * wc;
    return O_GC + 256 * (pn - 24) + 64 * wc + 32 * bj;
}
__device__ __forceinline__ void p0_prologue(KArgs Ap, LAS unsigned char* lds, int vcu, int G, int tid, int wave, int lane) {
    LAS float* scr = (LAS float*)(lds + wave * 16384);
    const int gw = vcu * NWAVES + wave, NGW = G * NWAVES;
    const float* w_in = Ap->in[2]; const float* w_out = Ap->in[10]; const float* ng = Ap->in[1]; unsigned char* ws = Ap->ws;
    bf16* BT1 = (bf16*)(ws + WS_BT1); bf16* BT2 = (bf16*)(ws + WS_BT2);
    constexpr int I1 = (N1 / 32) * 16, I2 = (DMODEL / 32) * (K2 / 64);
    for (int it = gw; it < I1 + I2; it += NGW) {
        if (it < I1) { const int rg = it >> 4, kb = it & 15; p0_transpose_item(w_in, IN_COLS, bt1_src(rg), ng, true, BT1, DMODEL, rg * 32, kb, scr, lane); }
        else { const int r = it - I1, n32 = r >> 5, kb = r & 31; p0_transpose_item(w_out, DMODEL, n32 * 32, ng, false, BT2, K2, n32 * 32, kb, scr, lane); }
    }
    __syncthreads();
    LAS v4u* wf = (LAS v4u*)lds;
    for (int e = tid; e < 32 * 64; e += NWAVES * 64) { const int kk = e >> 6, l = e & 63, kb = 32 * kk + 8 * (l >> 4), hd = l & 15; float v[8];
#pragma unroll
        for (int i = 0; i < 8; ++i) v[i] = w_in[(size_t)(kb + i) * IN_COLS + O_F + hd] * ng[kb + i];
        wf[e] = (v4u){pk2(v[0], v[1]), pk2(v[2], v[3]), pk2(v[4], v[5]), pk2(v[6], v[7])}; }
    __syncthreads();
    const float* x = Ap->in[0]; const float* bfg = Ap->in[3]; bf16* XN = (bf16*)(ws + WS_XN); float* RS = (float*)(ws + WS_RS); float* LF = (float*)(ws + WS_LF);
    const int fr = lane & 15, fq = lane >> 4;
    for (int grp = gw; grp < M / 16; grp += NGW) {
        const int r0 = grp * 16;
        const f32x4* __restrict__ xp = (const f32x4*)(x + (size_t)(r0 + fr) * DMODEL + 8 * fq); v4u* __restrict__ op = (v4u*)(XN + (size_t)(r0 + fr) * DMODEL + 8 * fq);
        pg8::f32x4 acc = {0.f, 0.f, 0.f, 0.f}; float ss = 0.f;
        f32x4 cur[8][2], nxt[8][2];
#pragma unroll
        for (int j = 0; j < 8; ++j) { cur[j][0] = __builtin_nontemporal_load(xp + 8 * j); cur[j][1] = __builtin_nontemporal_load(xp + 8 * j + 1); }
#pragma unroll
        for (int kb8 = 0; kb8 < 32; kb8 += 8) {
            if (kb8 + 8 < 32) {
#pragma unroll
                for (int j = 0; j < 8; ++j) { nxt[j][0] = __builtin_nontemporal_load(xp + 8 * (kb8 + 8 + j)); nxt[j][1] = __builtin_nontemporal_load(xp + 8 * (kb8 + 8 + j) + 1); }
            }
            asm volatile("" ::: "memory");
#pragma unroll
            for (int j = 0; j < 8; ++j) { const int kk = kb8 + j; const f32x4 a0 = cur[j][0], a1 = cur[j][1];
                ss += (a0.x * a0.x + a0.y * a0.y) + (a0.z * a0.z + a0.w * a0.w) + (a1.x * a1.x + a1.y * a1.y) + (a1.z * a1.z + a1.w * a1.w);
                const v4u av = {attn_body::cvtpk_s(a0.x, a0.y), attn_body::cvtpk_s(a0.z, a0.w), attn_body::cvtpk_s(a1.x, a1.y), attn_body::cvtpk_s(a1.z, a1.w)};
                op[4 * kk] = av;
                acc = __builtin_amdgcn_mfma_f32_16x16x32_bf16(__builtin_bit_cast(pg8::bf16x8, av), __builtin_bit_cast(pg8::bf16x8, wf[kk * 64 + lane]), acc, 0, 0, 0); }
            asm volatile("" ::: "memory");
#pragma unroll
            for (int j = 0; j < 8; ++j) { cur[j][0] = nxt[j][0]; cur[j][1] = nxt[j][1]; }
        }
        ss += __shfl_xor(ss, 16); ss += __shfl_xor(ss, 32);
        const float rs = 1.0f / sqrtf(ss * (1.f / DMODEL) + pg8::kEPS);
        if (fq == 0) RS[r0 + fr] = rs;
        const float bb = bfg[fr];
#pragma unroll
        for (int e = 0; e < 4; ++e) { const int r = 4 * fq + e; const float z = __shfl(rs, r) * acc[e] + bb;
            LF[(size_t)(r0 + r) * 16 + fr] = fminf(z, 0.f) - log1pf(expf(-fabsf(z))); }
    }
}

constexpr int CONV_BIG = 384;
__device__ __forceinline__ f32x2 unpk(unsigned w) { return (f32x2){bf_lo(w), bf_hi(w)}; }
__device__ __forceinline__ void conv_phase(KArgs Ap, LAS unsigned char* lds, int vcu, int G, int tid, int wave, int lane, size_t out_off) {
    (void)vcu; (void)G;
    LAS float* red = (LAS float*)lds;
    LAS f32x2* fin = (LAS f32x2*)(lds + 1024);
    const int c0 = 2 * tid;
    const float* cw = Ap->in[6]; unsigned char* ws = Ap->ws;
    f32x2 w[CK];
#pragma unroll
    for (int j = 0; j < CK; ++j) w[j] = *(const f32x2*)(cw + j * 1024 + c0);
    const f32x2 cb = *(const f32x2*)(Ap->in[7] + c0), lg = *(const f32x2*)(Ap->in[8] + c0), lb = *(const f32x2*)(Ap->in[9] + c0);
    const bf16* U = (const bf16*)(ws + WS_U); bf16* GC = (bf16*)(ws + WS_GC);
    unsigned* ctr = (unsigned*)(ws + WS_CTL) + CW_CONV; volatile LAS int* ubox = (volatile LAS int*)(lds + 2048);
    for (;;) {
        if (tid == 0) ubox[0] = (int)__hip_atomic_fetch_add(ctr, 1u, __ATOMIC_RELAXED, __HIP_MEMORY_SCOPE_AGENT);
        __syncthreads();
        const int unit = ubox[0];
        __syncthreads();
        if (unit >= CONV_BIG + (M - 64 * CONV_BIG) / 32) break;
        const bool big = unit < CONV_BIG; const int nch = big ? 8 : 4;
        const int row0 = big ? unit * 64 : 64 * CONV_BIG + (unit - CONV_BIG) * 32, t0 = row0 & (SEQ - 1);
        const bf16* Up = U + (size_t)row0 * 1024 + c0; bf16* Gp = GC + (size_t)row0 * 1024 + c0; bf16* Op = (bf16*)(ws + out_off) + (size_t)row0 * 1024 + c0;
        f32x2 win[38];
#pragma unroll
        for (int i = 0; i < 30; ++i) { const unsigned raw = (t0 - 30 + i >= 0) ? *(const unsigned*)(Up + (long)(i - 30) * 1024) : 0u; win[i] = unpk(raw); }
        unsigned nx[8], nx2[8], gcn[8];
#pragma unroll
        for (int i = 0; i < 8; ++i) nx[i] = *(const unsigned*)(Up + (long)i * 1024);
#pragma unroll
        for (int i = 0; i < 8; ++i) nx2[i] = *(const unsigned*)(Up + (long)(8 + i) * 1024);
#pragma unroll
        for (int i = 0; i < 8; ++i) gcn[i] = *(const unsigned*)(Gp + (long)i * 1024);
#pragma unroll 1
        for (int ch = 0; ch < nch; ++ch) {
            unsigned gcr[8];
#pragma unroll
            for (int i = 0; i < 8; ++i) { win[30 + i] = unpk(nx[i]); nx[i] = nx2[i]; gcr[i] = gcn[i]; }
            { const int c2 = (ch + 2 < nch) ? ch + 2 : nch - 1, c1 = (ch + 1 < nch) ? ch + 1 : nch - 1;
#pragma unroll
              for (int i = 0; i < 8; ++i) nx2[i] = *(const unsigned*)(Up + (long)(c2 * 8 + i) * 1024);
#pragma unroll
              for (int i = 0; i < 8; ++i) gcn[i] = *(const unsigned*)(Gp + (long)(c1 * 8 + i) * 1024); }
            f32x2 y[8];
#pragma unroll
            for (int i = 0; i < 8; ++i) { f32x2 a = cb;
#pragma unroll
                for (int j = 0; j < CK; ++j) a += w[j] * win[i + j];
                y[i] = a; }
            float st[16];
#pragma unroll
            for (int i = 0; i < 8; ++i) { st[2 * i] = y[i].x + y[i].y; st[2 * i + 1] = y[i].x * y[i].x + y[i].y * y[i].y; }
            {
#pragma unroll
              for (int k = 0; k < 8; ++k) { const auto r = __builtin_amdgcn_permlane32_swap(__float_as_uint(st[k]), __float_as_uint(st[k + 8]), false, false); st[k] = __uint_as_float(r[0]) + __uint_as_float(r[1]); }
#pragma unroll
              for (int k = 0; k < 4; ++k) { const auto r = __builtin_amdgcn_permlane16_swap(__float_as_uint(st[k]), __float_as_uint(st[k + 4]), false, false); st[k] = __uint_as_float(r[0]) + __uint_as_float(r[1]); }
              const bool h3 = (lane & 8) != 0;
#pragma unroll
              for (int k = 0; k < 2; ++k) { const float send = h3 ? st[k] : st[k + 2], keep = h3 ? st[k + 2] : st[k]; st[k] = keep + __shfl_xor(send, 8); }
              const bool h2 = (lane & 4) != 0;
              { const float send = h2 ? st[0] : st[1], keep = h2 ? st[1] : st[0]; st[0] = keep + __shfl_xor(send, 4); }
              st[0] += __shfl_xor(st[0], 2); st[0] += __shfl_xor(st[0], 1); }
            const int pb = ch & 1;
            if ((lane & 3) == 0) red[(pb * 8 + wave) * 16 + ((lane >> 2) & 15)] = st[0];
            __syncthreads();
            if (tid < 8) { float s1 = 0.f, s2 = 0.f;
#pragma unroll
                for (int wv = 0; wv < 8; ++wv) { s1 += red[(pb * 8 + wv) * 16 + 2 * tid]; s2 += red[(pb * 8 + wv) * 16 + 2 * tid + 1]; }
                const float mu = s1 * (1.f / 1024.f), var = fmaxf(s2 * (1.f / 1024.f) - mu * mu, 0.f);
                fin[pb * 8 + tid] = (f32x2){mu, 1.0f / sqrtf(var + pg8::kEPS)}; }
            __syncthreads();
#pragma unroll
            for (int i = 0; i < 8; ++i) { const f32x2 ms = fin[pb * 8 + i]; const f32x2 a = lg * ms.y, b = lb - a * ms.x; const f32x2 z = y[i] * a + b; const f32x2 gg = unpk(gcr[i]);
                const f32x2 t = z * (-pg8::kLOG2E); f32x2 d; d.x = __builtin_amdgcn_exp2f(t.x); d.y = __builtin_amdgcn_exp2f(t.y); d = d + 1.0f;
                f32x2 r; r.x = __builtin_amdgcn_rcpf(d.x); r.y = __builtin_amdgcn_rcpf(d.y);
                const f32x2 o = (z * r) * gg;
                *(unsigned*)(Op + (long)(ch * 8 + i) * 1024) = pg8::cvt_pk_bf16(o.x, o.y); }
#pragma unroll
            for (int i = 0; i < 30; ++i) asm("v_pk_mov_b32 %0, %1, %1 op_sel:[0,1]" : "=v"(win[i]) : "v"(win[i + 8]));
        }
    }
    __syncthreads();
}

__device__ __forceinline__ void build_bias_table(const float* LF, const float* gq, const float* gk, int bh, LAS unsigned char* lds, int tid, int wave, int lane) {
    LAS v4u* tab = (LAS v4u*)(lds + BT_OFF); LAS float* wtot = (LAS float*)(lds + WT_OFF); LAS float* te = (LAS float*)(lds + WT_OFF + 256);
    const int b = bh >> 4, h = bh & 15;
    const float* lf = LF + (size_t)b * SEQ * 16 + h;
    const int t0 = 4 * tid; float v[4];
#pragma unroll
    for (int i = 0; i < 4; ++i) v[i] = lf[(size_t)(t0 + i) * 16];
    v[1] += v[0]; v[2] += v[1]; v[3] += v[2];
    const float tot = v[3]; float inc = tot;
#pragma unroll
    for (int o = 1; o < 64; o <<= 1) { const float n = __shfl_up(inc, o); if (lane >= o) inc += n; }
    if (lane == 63) wtot[wave] = inc;
    __syncthreads();
    float off = inc - tot;
    for (int wv = 0; wv < wave; ++wv) off += wtot[wv];
#pragma unroll
    for (int i = 0; i < 4; ++i) { const float bias = -(v[i] + off) * pg8::kLOG2E;
        const unsigned b1 = f2bf(bias); const float r1 = bias - __uint_as_float(b1 << 16);
        const unsigned b2 = f2bf(r1);   const float r2 = r1 - __uint_as_float(b2 << 16);
        const unsigned b3 = f2bf(r2);
        tab[t0 + i] = (v4u){b1 | (b2 << 16), b3 | 0x3F800000u, 0x3F803F80u, 0u};
        if (i == 3 && (tid & 15) == 15) te[tid >> 4] = bias; }
    if (wave == 0) { float mq = fabsf(gq[h * 64 + lane]), mk = fabsf(gk[h * 64 + lane]);
#pragma unroll
        for (int o = 1; o < 64; o <<= 1) { mq = fmaxf(mq, __shfl_xor(mq, o)); mk = fmaxf(mk, __shfl_xor(mk, o)); }
        if (lane == 0) te[32] = 2.0f * (8.0f * pg8::kLOG2E * 1.03f * mq * mk) + 51.0f; }
    __syncthreads();
}
__global__ void __launch_bounds__(NWAVES * 64, 2) skel_fwd(Args args) {
    extern __shared__ __attribute__((aligned(16))) unsigned char lds_raw[];
    LAS unsigned char* lds = (LAS unsigned char*)lds_raw;
    const int G = gridDim.x, bx = blockIdx.x, vcu = (G % 8 == 0) ? (bx % 8) * (G / 8) + bx / 8 : bx;
#define PHASE_IDS() int tid = threadIdx.x; asm volatile("" : "+v"(tid)); const int lane = tid & 63, wave = __builtin_amdgcn_readfirstlane(tid >> 6); (void)lane; (void)wave
#define KARGS() ({ KArgs k_ = (KArgs)__builtin_amdgcn_kernarg_segment_ptr(); asm volatile("" : "+s"(k_)); k_; })
#if MK_N_LAUNCHES == 1
#define IN(k) true
#define GRID_BAR() xcd_barrier(bar)
#else
    const int lo = args.ph_lo, hi = args.ph_hi;
#define IN(k) (lo <= (k) && (k) < hi)
#define GRID_BAR() do {} while (0)
#endif

#if MK_N_LAUNCHES == 1
    if (threadIdx.x < 2) ((volatile LAS unsigned*)(lds + MISC_OFF))[threadIdx.x] = 0u;
    __syncthreads();
    XcdBarrier bar = xcd_barrier_post((unsigned*)(KARGS()->ws + WS_CTL), (volatile LAS unsigned*)(lds + MISC_OFF));
    if (KARGS()->ph_lo < 0) cg::this_grid().sync();
#endif
    if (IN(0)) { PHASE_IDS(); int nrep0 = (MK_PROBE == 1) ? 2 : 1; asm volatile("" : "+s"(nrep0));
#pragma unroll 1
        for (int r = 0; r < nrep0; ++r) { p0_prologue(KARGS(), lds, vcu, G, tid, wave, lane); __syncthreads(); }

 if (IN(1)) GRID_BAR(); }

    if (IN(1)) {
        KArgs Ap = KARGS(); unsigned char* ws = Ap->ws;
        pg8::Gemm g{(const bf16*)(ws + WS_XN), (const bf16*)(ws + WS_BT1), M, N1, DMODEL, DMODEL, 1 << 30, 0l}; pg8::StaticOrder S; S.init(M, N1, G, bx);
        pg8::Epi1 E{(bf16*)(ws + WS_Q), (const float*)(ws + WS_RS), Ap->in[4], Ap->in[5], lds + ESTG_OFF};
        int nrep1 = (MK_PROBE == 2) ? 2 : 1; asm volatile("" : "+s"(nrep1));
#pragma unroll 1
        for (int r = 0; r < nrep1; ++r) { pg8::gemm_phase<pg8::Epi1, pg8::StaticOrder, true, true>(lds, g, S, E); __syncthreads(); }
#if MK_N_LAUNCHES == 1
        { PHASE_IDS(); build_bias_table((const float*)(ws + WS_LF), Ap->in[4], Ap->in[5], (G == BATCH * NH) ? (vcu & ~15) + ((vcu & 15) >> 1) : vcu % (BATCH * NH), lds, tid, wave, lane); }
#endif
        if (IN(2)) GRID_BAR();
    }

    if (IN(2)) {
        { PHASE_IDS();
        unsigned char* ws = KARGS()->ws;
        const attn_body::bf16* QB = (const attn_body::bf16*)(ws + WS_Q);
        int cur_bh = (MK_N_LAUNCHES == 1) ? ((G == BATCH * NH) ? (vcu & ~15) + ((vcu & 15) >> 1) : vcu % (BATCH * NH)) : -1;
        int pass0 = (MK_PROBE == 4) ? 0 : 1; asm volatile("" : "+s"(pass0));
#pragma unroll 1
        for (int pass = pass0; pass < 2; ++pass)
        for (int ui = 0; (G == BATCH * NH) ? ui < SEQ / 256 : vcu + ui * G < BATCH * NH * (SEQ / 256); ++ui) {
            int bh, qb;
            if (G == BATCH * NH) { const int j = (vcu & 15) >> 1, sx = vcu & 1, grp = ui >> 2, set = grp ? 1 - sx : sx, k4 = 4 * (ui & 3);
                qb = ((set ? 0x6521 : 0x7430) >> k4) & 15; bh = (vcu & ~15) + (grp ? 15 - j : j); }
            else { const int L = vcu + ui * G; bh = L % (BATCH * NH); qb = L / (BATCH * NH); }
            if (bh != cur_bh) { KArgs Aq = KARGS(); build_bias_table((const float*)(ws + WS_LF), Aq->in[4], Aq->in[5], bh, lds, tid, wave, lane); cur_bh = bh; }
            int ts = 0;
            if (qb > 0) { const LAS float* te = (const LAS float*)(lds + WT_OFF + 256); const float ref = te[4 * qb - 1], th = te[32];
                const bool c = lane < 32 && lane < 4 * qb && (ref - te[lane & 31] > th); ts = (int)__popcll(__ballot(c)) & ~1; }
            ts = __builtin_amdgcn_readfirstlane(ts);
#ifndef NO_ATTN
            attn_body::attn_unit<96>(bh >> 4, bh & 15, qb, ts, QB, QB + pg8::Epi1::ZS, QB + 2 * pg8::Epi1::ZS, pass ? (attn_body::bf16*)QB : (attn_body::bf16*)(ws + WS_XN), QB + 3 * pg8::Epi1::ZS, (char*)lds_raw, (attn_body::lds_cptr)(lds + BT_OFF));
#endif
        }
        }
        __syncthreads();
#ifndef NO_CONV
        { PHASE_IDS(); conv_phase(KARGS(), lds, vcu, G, tid, wave, lane, WS_GC); }
#endif
        if (IN(3)) GRID_BAR();
    }

    if (IN(3)) {
        KArgs Ap = KARGS(); unsigned char* ws = Ap->ws;
        pg8::Gemm g{(const bf16*)(ws + WS_Q), (const bf16*)(ws + WS_BT2), M, DMODEL, K2, DMODEL, 16, (long)(WS_GC - WS_Q) - 16l * 128l}; pg8::StaticOrder S; S.init(M, DMODEL, G, bx);
        pg8::Epi2 E{Ap->in[0], Ap->out, lds + ESTG_OFF};
        int nrep3 = (MK_PROBE == 5) ? 2 : 1; asm volatile("" : "+s"(nrep3));
#pragma unroll 1
        for (int r = 0; r < nrep3; ++r) { pg8::gemm_phase<pg8::Epi2, pg8::StaticOrder, true, true>(lds, g, S, E); __syncthreads(); }
    }
#undef KARGS
#undef IN
}

extern "C" void kernel_launch(void* const* d_in, const int* in_sizes, int n_in, void* d_out, int out_size, void* d_ws, size_t ws_size, hipStream_t stream) {
    static int grid = 0;
    if (grid == 0) {
        if (n_in != 11 || in_sizes[0] != M * DMODEL || out_size != M * DMODEL || ws_size < WS_END) { fprintf(stderr, "kernel_launch: shape/workspace mismatch (n_in %d, in0 %d, out %d, ws %zu)\n", n_in, n_in > 0 ? in_sizes[0] : -1, out_size, ws_size); grid = -1; return; }
        int dev = 0, cus = 0, per_cu = 0;
        if (hipGetDevice(&dev) != hipSuccess || hipDeviceGetAttribute(&cus, hipDeviceAttributeMultiprocessorCount, dev) != hipSuccess) { grid = -1; return; }
        if (hipFuncSetAttribute((const void*)skel_fwd, hipFuncAttributeMaxDynamicSharedMemorySize, LDS_BYTES) != hipSuccess) { fprintf(stderr, "kernel_launch: hipFuncSetAttribute failed\n"); grid = -1; return; }
        if (hipOccupancyMaxActiveBlocksPerMultiprocessor(&per_cu, (const void*)skel_fwd, NWAVES * 64, LDS_BYTES) != hipSuccess || per_cu < 1) { fprintf(stderr, "kernel_launch: occupancy query says %d blocks per CU\n", per_cu); per_cu = 1; }
        (void)hipGetLastError();
        grid = cus;
    }
    if (grid < 0) return;
    if (hipMemsetAsync((char*)d_ws + WS_CTL, 0, CTL_ZERO_BYTES, stream) != hipSuccess) { fprintf(stderr, "kernel_launch: hipMemsetAsync failed\n"); return; }
    Args a{};
    for (int i = 0; i < 11; ++i) a.in[i] = (const float*)d_in[i];
    a.out = (float*)d_out; a.ws = (unsigned char*)d_ws;
#if MK_N_LAUNCHES == 1
    a.ph_lo = 0; a.ph_hi = 4;
    void* kargs[] = {&a};
    hipError_t e = hipLaunchCooperativeKernel((const void*)skel_fwd, dim3(grid), dim3(NWAVES * 64), kargs, LDS_BYTES, stream);
    if (e != hipSuccess) fprintf(stderr, "cooperative launch failed: %s (grid %d)\n", hipGetErrorString(e), grid);
#else
    for (int p = 0; p < 4; ++p) { a.ph_lo = p; a.ph_hi = p + 1; hipLaunchKernelGGL(skel_fwd, dim3(grid), dim3(NWAVES * 64), LDS_BYTES, stream, a); }
#endif
}
```
